# Optimizing an MI355X kernel written in HIP

```python
import math
import jax, jax.numpy as jnp
from jax import lax
import numpy as np

D_MODEL = 1024
BATCH = 32
SEQ = 256
DEPTH = 2
DEC_BATCH = 2
DEC_SEQ = 4096
PAST_LEN = 256

GRID_W = 64
D_A = 512
CONV_K = 31
CONV_PAD = (CONV_K - 1) // 2
H_B = 4
DK_B = 128
DV_B = 128
D_B = H_B * DV_B
CHUNK = 32
H_C = 4
DH_C = 64
D_C = H_C * 2 * DH_C
QBLK = 128
ROPE_BASE = 10000.0
D_FF = ((8 * D_MODEL + 3 * 256 - 1) // (3 * 256)) * 256
SPLIT_SIZES = (2 * D_A, D_B, D_B, D_B, D_B, D_B, D_C, D_C, D_C, 3 * D_MODEL)
IN_COLS = 2 * D_A + 5 * D_B + 3 * D_C + 3 * D_MODEL
N_BRANCH = 3

kernel_name = 'hybrid_diffusion_conv_hgrn2_diffattn_step'


def rmsnorm(x, g, eps=1e-6):
    xf = x.astype(jnp.float32)
    y = xf * lax.rsqrt(jnp.mean(xf * xf, axis=-1, keepdims=True) + eps)
    return (y * g.astype(jnp.float32)).astype(x.dtype)


def layernorm(x, g, b, eps=1e-5):
    xf = x.astype(jnp.float32)
    mu = jnp.mean(xf, axis=-1, keepdims=True)
    xc = xf - mu
    y = xc * lax.rsqrt(jnp.mean(xc * xc, axis=-1, keepdims=True) + eps)
    return (y * g.astype(jnp.float32) + b.astype(jnp.float32)).astype(x.dtype)


def axial_rope(n):
    rows = n // GRID_W
    row = jnp.broadcast_to(jnp.arange(rows)[:, None], (rows, GRID_W)).reshape(-1).astype(jnp.float32)
    col = jnp.broadcast_to(jnp.arange(GRID_W)[None, :], (rows, GRID_W)).reshape(-1).astype(jnp.float32)
    half = DH_C // 2
    inv = ROPE_BASE ** (-jnp.arange(0, half, 2, dtype=jnp.float32) / half)
    ang = jnp.concatenate([row[:, None] * inv, col[:, None] * inv], axis=-1)
    return jnp.cos(ang), jnp.sin(ang)


def apply_rope(x, cos, sin):
    c = cos[None, :, None, None, :].astype(x.dtype)
    s = sin[None, :, None, None, :].astype(x.dtype)
    x1 = x[..., 0::2]
    x2 = x[..., 1::2]
    return jnp.stack([x1 * c - x2 * s, x1 * s + x2 * c], axis=-1).reshape(x.shape)


def gla_chunk_scan(q, k, v, logf, s0):
    B, N, H, _ = q.shape
    DV = v.shape[-1]
    n = N // CHUNK

    def blocks(t):
        return t.reshape(B, n, CHUNK, H, t.shape[-1]).transpose(1, 0, 3, 2, 4)

    causal = jnp.tril(jnp.ones((CHUNK, CHUNK), dtype=bool))[:, :, None]

    def step(S, inp):
        qc, kc, vc, gc = inp
        b = jnp.cumsum(gc, axis=2)
        o_inter = jnp.einsum('bhtd,bhde->bhte', qc * jnp.exp(b), S)
        diff = b[:, :, :, None, :] - b[:, :, None, :, :]
        decay = jnp.where(causal, jnp.exp(jnp.where(causal, diff, 0.0)), 0.0)
        a = jnp.einsum('bhtsd,bhsd->bhts', qc[:, :, :, None, :] * decay, kc)
        o_intra = jnp.einsum('bhts,bhse->bhte', a, vc)
        b_last = b[:, :, -1:, :]
        S = jnp.exp(b_last[:, :, 0, :])[..., None] * S + jnp.einsum('bhsd,bhse->bhde', kc * jnp.exp(b_last - b), vc)
        return S, o_inter + o_intra

    s_fin, o = lax.scan(step, s0, (blocks(q), blocks(k), blocks(v), blocks(logf)))
    o = o.transpose(1, 0, 3, 2, 4).reshape(B, N, H, DV)
    return o, s_fin


def diff_attention(q, k, v, lam):
    B, N, H, _, DH = q.shape
    nb = N // QBLK
    qb = jnp.moveaxis(q.reshape(B, nb, QBLK, H, 2, DH), 1, 0)
    scale = DH ** -0.5

    def one_block(qblk):
        s = jnp.einsum('bqhcd,bkhcd->bhcqk', qblk, k, preferred_element_type=jnp.float32) * scale
        p = jax.nn.softmax(s, axis=-1)
        w = (p[:, :, 0] - lam * p[:, :, 1]).astype(v.dtype)
        return jnp.einsum('bhqk,bkhe->bqhe', w, v)

    o = lax.map(one_block, qb)
    return jnp.moveaxis(o, 0, 1).reshape(B, N, H, v.shape[-1])


def trunk_layer(x, cvec, l, rope, ctx, params):
    (w_mod, b_mod, norm1, norm2, w_in, conv_w, conv_b, conv_ln_g, conv_ln_b, hgrn_lb, hgrn_norm,
     q_norm, k_norm, lambda_qk, subln, w_branch, w_out, w_ffn_in, w_ffn_out) = params
    B, N, _ = x.shape
    f32 = jnp.float32

    mod = jnp.dot(jax.nn.silu(cvec), w_mod[l]) + b_mod[l]
    sh1, sc1, g1, sh2, sc2, g2 = jnp.split(mod[:, None, :], 6, axis=-1)

    h = rmsnorm(x, norm1[l]) * (1 + sc1) + sh1
    u = h @ w_in[l]
    idx = np.cumsum(SPLIT_SIZES)[:-1].tolist()
    a_glu, hq, hi, hf_f, hf_b, hg, aq, ak, av, gates = jnp.split(u, idx, axis=-1)

    a = a_glu[..., :D_A] * jax.nn.sigmoid(a_glu[..., D_A:])
    a = lax.conv_general_dilated(a, conv_w[l][:, None, :], (1,), [(CONV_PAD, CONV_PAD)],
                                 dimension_numbers=('NWC', 'WIO', 'NWC'), feature_group_count=D_A) + conv_b[l]
    a = jax.nn.silu(layernorm(a, conv_ln_g[l], conv_ln_b[l]))
    y_a = a @ w_branch[l, :D_A]

    sm = jax.nn.softmax(hgrn_lb.astype(f32), axis=0)
    lb = (jnp.cumsum(sm, axis=0)[l] - sm[0]).reshape(2, 1, 1, H_B, DK_B)
    z = jnp.stack([hf_f, hf_b], axis=0).astype(f32).reshape(2, B, N, H_B, DK_B)
    fgate = lb + (1.0 - lb) * jax.nn.sigmoid(z)
    kgate = 1.0 - fgate
    logf = jnp.log(fgate)
    qb_ = jax.nn.silu(hq.astype(f32)).reshape(B, N, H_B, DK_B)
    vb_ = hi.astype(f32).reshape(B, N, H_B, DV_B)
    if ctx is None:
        s0 = jnp.zeros((B, 2, H_B, DK_B, DV_B), f32)
    else:
        s0 = jnp.broadcast_to(ctx[2].astype(f32), (B, 2, H_B, DK_B, DV_B))
    o_f, s_f = gla_chunk_scan(qb_, kgate[0], vb_, logf[0], s0[:, 0])
    fl = lambda t: jnp.flip(t, axis=1)
    o_b, s_b = gla_chunk_scan(fl(qb_), fl(kgate[1]), fl(vb_), fl(logf[1]), s0[:, 1])
    o_hg = rmsnorm(o_f + fl(o_b), hgrn_norm[l]) * jax.nn.silu(hg.astype(f32).reshape(B, N, H_B, DV_B))
    y_b = o_hg.reshape(B, N, D_B).astype(x.dtype) @ w_branch[l, D_A:D_A + D_B]
    new_s = jnp.stack([s_f, s_b], axis=1).astype(x.dtype)

    q = rmsnorm(aq.reshape(B, N, H_C, 2, DH_C), q_norm[l])
    k = rmsnorm(ak.reshape(B, N, H_C, 2, DH_C), k_norm[l])
    v = av.reshape(B, N, H_C, 2 * DH_C)
    if rope is not None:
        q = apply_rope(q, rope[0], rope[1])
        k = apply_rope(k, rope[0], rope[1])
    if ctx is None:
        k_all, v_all = k, v
    else:
        k_all = jnp.concatenate([ctx[0].astype(k.dtype), k], axis=1)
        v_all = jnp.concatenate([ctx[1].astype(v.dtype), v], axis=1)
    lam_init = 0.8 - 0.6 * math.exp(-0.3 * l)
    lq = lambda_qk[l].astype(f32)
    lam = jnp.exp(jnp.sum(lq[0] * lq[1])) - jnp.exp(jnp.sum(lq[2] * lq[3])) + lam_init
    o_c = diff_attention(q, k_all, v_all, lam)
    o_c = rmsnorm(o_c, subln[l]) * (1.0 - lam_init)
    y_c = o_c.reshape(B, N, D_C) @ w_branch[l, D_A + D_B:]

    s = jax.nn.sigmoid(gates.reshape(B, N, N_BRANCH, D_MODEL))
    m = s[:, :, 0] * y_a + s[:, :, 1] * y_b + s[:, :, 2] * y_c
    x = x + g1 * (m @ w_out[l])

    h2 = rmsnorm(x, norm2[l]) * (1 + sc2) + sh2
    gu = h2 @ w_ffn_in[l]
    ff = jax.nn.silu(gu[..., :D_FF]) * gu[..., D_FF:]
    x = x + g2 * (ff @ w_ffn_out[l])
    return x, k, v, new_s


def setup_inputs(seed: int = 0) -> dict:
    key = jax.random.key(seed)
    ks = jax.random.split(key, 32)
    nrm = lambda i, shape, sc: jax.random.normal(ks[i], shape, jnp.float32) * sc
    D = D_MODEL
    return {
        'x_prompt': nrm(0, (BATCH, SEQ, D), 1.0),
        'x_sample': nrm(1, (DEC_BATCH, DEC_SEQ, D), 1.0),
        'cache_k': nrm(2, (DEC_BATCH, DEPTH, PAST_LEN, H_C, 2, DH_C), 1.0),
        'cache_v': nrm(3, (DEC_BATCH, DEPTH, PAST_LEN, H_C, 2 * DH_C), 1.0),
        'state_hgrn': nrm(4, (DEC_BATCH, DEPTH, 2, H_B, DK_B, DV_B), 0.5),
        'c': nrm(5, (DEC_BATCH, D), 1.0),
        'c_ctx': nrm(6, (D,), 1.0),
        'w_mod': nrm(7, (DEPTH, D, 6 * D), 0.5 * D ** -0.5),
        'b_mod': nrm(8, (DEPTH, 6 * D), 0.02),
        'norm1': 1.0 + nrm(9, (DEPTH, D), 0.05),
        'norm2': 1.0 + nrm(10, (DEPTH, D), 0.05),
        'w_in': nrm(11, (DEPTH, D, IN_COLS), D ** -0.5),
        'conv_w': nrm(12, (DEPTH, CONV_K, D_A), CONV_K ** -0.5),
        'conv_b': nrm(13, (DEPTH, D_A), 0.02),
        'conv_ln_g': 1.0 + nrm(14, (DEPTH, D_A), 0.05),
        'conv_ln_b': nrm(15, (DEPTH, D_A), 0.02),
        'hgrn_lb': nrm(16, (DEPTH, 2, D_B), 0.1),
        'hgrn_norm': 1.0 + nrm(17, (DEPTH, DV_B), 0.05),
        'q_norm': 1.0 + nrm(18, (DEPTH, DH_C), 0.05),
        'k_norm': 1.0 + nrm(19, (DEPTH, DH_C), 0.05),
        'lambda_qk': nrm(20, (DEPTH, 4, DH_C), 0.1),
        'subln': 1.0 + nrm(21, (DEPTH, 2 * DH_C), 0.05),
        'w_branch': nrm(22, (DEPTH, D_A + D_B + D_C, D), 512 ** -0.5),
        'w_out': nrm(23, (DEPTH, D, D), D ** -0.5),
        'w_ffn_in': nrm(24, (DEPTH, D, 2 * D_FF), D ** -0.5),
        'w_ffn_out': nrm(25, (DEPTH, D_FF, D), D_FF ** -0.5),
    }


def reference(x_prompt, x_sample, cache_k, cache_v, state_hgrn, c, c_ctx, w_mod, b_mod, norm1, norm2, w_in,
              conv_w, conv_b, conv_ln_g, conv_ln_b, hgrn_lb, hgrn_norm, q_norm, k_norm, lambda_qk, subln,
              w_branch, w_out, w_ffn_in, w_ffn_out):
    params = (w_mod, b_mod, norm1, norm2, w_in, conv_w, conv_b, conv_ln_g, conv_ln_b, hgrn_lb, hgrn_norm,
              q_norm, k_norm, lambda_qk, subln, w_branch, w_out, w_ffn_in, w_ffn_out)

    xp = x_prompt
    cvec_ctx = c_ctx[None, :]
    ks, vs, ss = [], [], []
    for l in range(DEPTH):
        xp, k_l, v_l, s_l = trunk_layer(xp, cvec_ctx, l, None, None, params)
        ks.append(k_l)
        vs.append(v_l)
        ss.append(s_l)
    new_cache_k = jnp.stack(ks, axis=1)
    new_cache_v = jnp.stack(vs, axis=1)
    new_state_hgrn = jnp.stack(ss, axis=1)

    xs = x_sample
    rope = axial_rope(xs.shape[1])
    for l in range(DEPTH):
        ctx = (cache_k[:, l], cache_v[:, l], state_hgrn[:, l])
        xs, _, _, _ = trunk_layer(xs, c, l, rope, ctx, params)

    return (xp, xs, new_cache_k, new_cache_v, new_state_hgrn)
```

```cpp
#include <hip/hip_runtime.h>
#include <hip/hip_cooperative_groups.h>
#include <cstdio>
namespace cg = cooperative_groups;

#ifndef MEGA
#define MEGA 1
#endif

#define DI __device__ __forceinline__
typedef unsigned short bf16_t;
typedef __attribute__((ext_vector_type(8))) short bf16x8;
typedef __attribute__((ext_vector_type(4))) short s16x4;
typedef __attribute__((ext_vector_type(16))) float f32x16;
typedef __attribute__((ext_vector_type(2))) float f32x2;
typedef __attribute__((ext_vector_type(4))) unsigned u32x4;
typedef __attribute__((ext_vector_type(2))) __bf16 bf16x2_t;
#define MFMA(a, b, c) __builtin_amdgcn_mfma_f32_32x32x16_bf16((a), (b), (c), 0, 0, 0)

DI unsigned pk2(float a, float b) { f32x2 v = {a, b}; return __builtin_bit_cast(unsigned, __builtin_convertvector(v, bf16x2_t)); }
DI bf16_t f2bf(float a) { return (bf16_t)(pk2(a, 0.f) & 0xffffu); }
DI float bf2f(bf16_t v) { return __uint_as_float(((unsigned)v) << 16); }
DI float bflo(unsigned u) { return __uint_as_float(u << 16); }
DI float bfhi(unsigned u) { return __uint_as_float(u & 0xffff0000u); }
DI float sigm(float x) { return 1.f / (1.f + __expf(-x)); }
DI float silu(float x) { return x / (1.f + __expf(-x)); }
DI bf16x8 pack8(float a0, float a1, float a2, float a3, float a4, float a5, float a6, float a7) {
  uint4 u; u.x = pk2(a0, a1); u.y = pk2(a2, a3); u.z = pk2(a4, a5); u.w = pk2(a6, a7);
  return __builtin_bit_cast(bf16x8, u);
}
#define PACK_STEP(x, s) pack8(x[8*(s)+0], x[8*(s)+1], x[8*(s)+2], x[8*(s)+3], x[8*(s)+4], x[8*(s)+5], x[8*(s)+6], x[8*(s)+7])
DI bf16x8 ld_perm(const bf16_t* p) {
  s16x4 lo = *(const s16x4*)p; s16x4 hi = *(const s16x4*)(p + 8);
  return __builtin_shufflevector(lo, hi, 0, 1, 2, 3, 4, 5, 6, 7);
}
DI int crow(int i, int hh) { return (i & 3) + 8 * (i >> 2) + 4 * hh; }
DI f32x16 zero16() { f32x16 z; for (int i = 0; i < 16; ++i) z[i] = 0.f; return z; }

constexpr int TOK = 8192;
constexpr int DFF = 2816;
constexpr size_t alignup(size_t x) { return (x + 255) & ~(size_t)255; }
constexpr size_t OFF_WIN  = 0;
constexpr size_t OFF_WBR  = OFF_WIN  + (size_t)8192 * 1024 * 2;
constexpr size_t OFF_WOUT = OFF_WBR  + (size_t)1024 * 1536 * 2;
constexpr size_t OFF_WFI  = OFF_WOUT + (size_t)1024 * 1024 * 2;
constexpr size_t OFF_WFO  = OFF_WFI  + (size_t)5632 * 1024 * 2;
constexpr size_t WSET     = OFF_WFO  + (size_t)1024 * 2816 * 2;
constexpr size_t OFF_MOD  = 2 * WSET;
constexpr size_t OFF_MISC = OFF_MOD  + (size_t)2 * 3 * 6144 * 4;
constexpr size_t OFF_ROPE = OFF_MISC + 4096;
constexpr size_t OFF_H    = OFF_ROPE + (size_t)4096 * 32 * 2 * 4;
constexpr size_t OFF_SEGA = OFF_H    + (size_t)TOK * 1024 * 2;
constexpr size_t OFF_SEGH = OFF_SEGA + (size_t)TOK * 1024 * 2;
constexpr size_t OFF_SEGC = OFF_SEGH + (size_t)TOK * 2560 * 2;
constexpr size_t OFF_SEGG = OFF_SEGC + (size_t)TOK * 1536 * 2;
constexpr size_t OFF_QN   = OFF_SEGG + (size_t)TOK * 3072 * 2;
constexpr size_t OFF_KB   = OFF_QN   + (size_t)TOK * 512 * 2;
constexpr size_t OFF_VT   = OFF_KB   + (size_t)2 * 4 * 2 * 4352 * 64 * 2;
constexpr size_t OFF_ACTA = OFF_VT   + (size_t)2 * 4 * 128 * 4352 * 2;
constexpr size_t OFF_SLOC = OFF_ACTA + (size_t)TOK * 512 * 2;
constexpr size_t OFF_BTOT = OFF_SLOC + (size_t)2 * 4 * 2 * 16 * 16384 * 4;
constexpr size_t OFF_BAR  = OFF_BTOT + (size_t)2 * 4 * 2 * 16 * 128 * 4;
constexpr size_t WS_END   = OFF_BAR + 16384;
constexpr size_t OFF_ACTB = OFF_SEGA;
constexpr size_t OFF_OC   = OFF_SEGC;
constexpr size_t OFF_OSC  = OFF_SEGC + (size_t)TOK * 512 * 2;
constexpr size_t OFF_OSB  = OFF_SEGA + (size_t)TOK * 512 * 2;
constexpr size_t OFF_M    = OFF_H;
constexpr size_t OFF_FF   = OFF_SEGG;

constexpr size_t OUT_CK = (size_t)2 * TOK * 1024;
constexpr size_t OUT_CV = OUT_CK + (size_t)32 * 2 * 256 * 512;
constexpr size_t OUT_ST = OUT_CV + (size_t)32 * 2 * 256 * 512;

constexpr float QSCALE = 0.125f * 1.4426950408889634f;

struct Params { const float* in[26]; float* out; char* ws; };

constexpr int SMEM_BYTES = 73728;

constexpr int GST = 128 * 72;
template <bool DEEP>
DI void gemm_main(f32x16 (&acc)[2][2], const bf16_t* a0, size_t lda32, const bf16_t* b0, const bf16_t* b1, const bf16_t* b2, const bf16_t* b3,
                  int nk, bf16_t* sA, bf16_t* sB, int tid) {
  const int lane = tid & 63, w = tid >> 6, wm = w >> 1, wn = w & 1, r = lane & 31, hh = lane >> 5;
  const int so = (tid >> 3) * 72 + (tid & 7) * 8;
  const bf16_t* a1 = a0 + lda32; const bf16_t* a2 = a1 + lda32; const bf16_t* a3 = a2 + lda32;
  u32x4 pa0, pa1, pa2, pa3, pb0, pb1, pb2, pb3;
  u32x4 qa0, qa1, qa2, qa3, qb0, qb1, qb2, qb3;
#define GLD_P(OFF) { pa0 = *(const u32x4*)(a0 + (OFF)); pa1 = *(const u32x4*)(a1 + (OFF)); pa2 = *(const u32x4*)(a2 + (OFF)); pa3 = *(const u32x4*)(a3 + (OFF)); \
                     pb0 = *(const u32x4*)(b0 + (OFF)); pb1 = *(const u32x4*)(b1 + (OFF)); pb2 = *(const u32x4*)(b2 + (OFF)); pb3 = *(const u32x4*)(b3 + (OFF)); }
#define GLD_Q(OFF) { qa0 = *(const u32x4*)(a0 + (OFF)); qa1 = *(const u32x4*)(a1 + (OFF)); qa2 = *(const u32x4*)(a2 + (OFF)); qa3 = *(const u32x4*)(a3 + (OFF)); \
                     qb0 = *(const u32x4*)(b0 + (OFF)); qb1 = *(const u32x4*)(b1 + (OFF)); qb2 = *(const u32x4*)(b2 + (OFF)); qb3 = *(const u32x4*)(b3 + (OFF)); }
#define LST_P(ST) { bf16_t* nA_ = sA + (ST) * GST + so; bf16_t* nB_ = sB + (ST) * GST + so; \
    *(u32x4*)(nA_) = pa0; *(u32x4*)(nA_ + 32 * 72) = pa1; *(u32x4*)(nA_ + 64 * 72) = pa2; *(u32x4*)(nA_ + 96 * 72) = pa3; \
    *(u32x4*)(nB_) = pb0; *(u32x4*)(nB_ + 32 * 72) = pb1; *(u32x4*)(nB_ + 64 * 72) = pb2; *(u32x4*)(nB_ + 96 * 72) = pb3; }
#define LST_Q(ST) { bf16_t* nA_ = sA + (ST) * GST + so; bf16_t* nB_ = sB + (ST) * GST + so; \
    *(u32x4*)(nA_) = qa0; *(u32x4*)(nA_ + 32 * 72) = qa1; *(u32x4*)(nA_ + 64 * 72) = qa2; *(u32x4*)(nA_ + 96 * 72) = qa3; \
    *(u32x4*)(nB_) = qb0; *(u32x4*)(nB_ + 32 * 72) = qb1; *(u32x4*)(nB_ + 64 * 72) = qb2; *(u32x4*)(nB_ + 96 * 72) = qb3; }
#define GCOMPUTE(ST) { const bf16_t* cA = sA + (ST) * GST + (wm * 64 + r) * 72 + hh * 8; const bf16_t* cB = sB + (ST) * GST + (wn * 64 + r) * 72 + hh * 8; \
  if (DEEP) { \
    bf16x8 fa0[4], fa1[4], fb0[4], fb1[4]; \
    _Pragma("unroll") for (int ks = 0; ks < 4; ++ks) { \
      fa0[ks] = *(const bf16x8*)(cA + ks * 16); fa1[ks] = *(const bf16x8*)(cA + 32 * 72 + ks * 16); \
      fb0[ks] = *(const bf16x8*)(cB + ks * 16); fb1[ks] = *(const bf16x8*)(cB + 32 * 72 + ks * 16); } \
    __builtin_amdgcn_sched_barrier(0); \
    _Pragma("unroll") for (int ks = 0; ks < 4; ++ks) { \
      acc[0][0] = MFMA(fa0[ks], fb0[ks], acc[0][0]); acc[0][1] = MFMA(fa0[ks], fb1[ks], acc[0][1]); \
      acc[1][0] = MFMA(fa1[ks], fb0[ks], acc[1][0]); acc[1][1] = MFMA(fa1[ks], fb1[ks], acc[1][1]); } \
  } else { \
    __builtin_amdgcn_s_setprio(1); \
    _Pragma("unroll") for (int ks = 0; ks < 4; ++ks) { \
      bf16x8 fa0 = *(const bf16x8*)(cA + ks * 16), fa1 = *(const bf16x8*)(cA + 32 * 72 + ks * 16); \
      bf16x8 fb0 = *(const bf16x8*)(cB + ks * 16), fb1 = *(const bf16x8*)(cB + 32 * 72 + ks * 16); \
      acc[0][0] = MFMA(fa0, fb0, acc[0][0]); acc[0][1] = MFMA(fa0, fb1, acc[0][1]); \
      acc[1][0] = MFMA(fa1, fb0, acc[1][0]); acc[1][1] = MFMA(fa1, fb1, acc[1][1]); } \
    __builtin_amdgcn_s_setprio(0); } }
  GLD_P(0);
  __syncthreads();
  LST_P(0);
  if (!DEEP) {
    __syncthreads();
    for (int kt = 0; kt < nk; kt += 2) {
      GLD_P((size_t)(kt + 1) * 64);
      GCOMPUTE(0);
      LST_P(1);
      __syncthreads();
      const bool m2 = kt + 2 < nk;
      if (m2) GLD_P((size_t)(kt + 2) * 64);
      GCOMPUTE(1);
      if (m2) LST_P(0);
      __syncthreads();
    }
    return;
  }
  GLD_P(64);
  __syncthreads();
  for (int kt = 0; kt < nk; kt += 2) {
    const bool m2 = kt + 2 < nk;
    const size_t o2 = (size_t)(kt + 2) * 64;
    if (m2) GLD_Q(o2);
    __builtin_amdgcn_sched_barrier(0);
    GCOMPUTE(0);
    __builtin_amdgcn_sched_barrier(0);
    LST_P(1);
    __syncthreads();
    if (m2) GLD_P(o2 + 64);
    __builtin_amdgcn_sched_barrier(0);
    GCOMPUTE(1);
    __builtin_amdgcn_sched_barrier(0);
    if (m2) LST_Q(0);
    __syncthreads();
  }
#undef GLD_P
#undef GLD_Q
#undef LST_P
#undef LST_Q
#undef GCOMPUTE
}

DI void convert_tile(const Params& p, int layer, int t, char* smem, int tid) {
  const float* src; bf16_t* dst; int K, N;
  char* wb = p.ws + (size_t)layer * WSET;
  if (t < 1024)      { src = p.in[11] + (size_t)layer * 1024 * 8192; dst = (bf16_t*)(wb + OFF_WIN);  K = 1024; N = 8192; }
  else if (t < 1216) { t -= 1024; src = p.in[22] + (size_t)layer * 1536 * 1024; dst = (bf16_t*)(wb + OFF_WBR);  K = 1536; N = 1024; }
  else if (t < 1344) { t -= 1216; src = p.in[23] + (size_t)layer * 1024 * 1024; dst = (bf16_t*)(wb + OFF_WOUT); K = 1024; N = 1024; }
  else if (t < 2048) { t -= 1344; src = p.in[24] + (size_t)layer * 1024 * 5632; dst = (bf16_t*)(wb + OFF_WFI);  K = 1024; N = 5632; }
  else               { t -= 2048; src = p.in[25] + (size_t)layer * 2816 * 1024; dst = (bf16_t*)(wb + OFF_WFO);  K = 2816; N = 1024; }
  const int tn = N >> 8;
  const int n0 = (t % tn) * 256, k0 = (t / tn) * 32;
  float* T = (float*)smem;
  __syncthreads();
  {
    const float* sp = src + (size_t)(k0 + (tid >> 6)) * N + n0 + (tid & 63) * 4;
    float4 v[8];
#pragma unroll
    for (int i = 0; i < 8; ++i) v[i] = *(const float4*)(sp + (size_t)(i * 4) * N);
#pragma unroll
    for (int i = 0; i < 8; ++i) *(float4*)(T + (i * 4 + (tid >> 6)) * 260 + (tid & 63) * 4) = v[i];
  }
  __syncthreads();
  {
    float x[32];
#pragma unroll
    for (int k = 0; k < 32; ++k) x[k] = T[k * 260 + tid];
    bf16_t* dp = dst + (size_t)(n0 + tid) * K + k0;
#pragma unroll
    for (int q = 0; q < 4; ++q)
      *(bf16x8*)(dp + 8 * q) = pack8(x[8 * q], x[8 * q + 1], x[8 * q + 2], x[8 * q + 3], x[8 * q + 4], x[8 * q + 5], x[8 * q + 6], x[8 * q + 7]);
  }
}

DI void mod_item(const Params& p, int it, char* smem, int tid) {
  const int l = it / 96, chunk = it % 96;
  const int lane = tid & 63, w = tid >> 6;
  const int n = chunk * 64 + lane;
  const float* wm = p.in[7] + (size_t)l * 1024 * 6144;
  const float* c0 = p.in[6]; const float* c1 = p.in[5]; const float* c2 = p.in[5] + 1024;
  float a0 = 0.f, a1 = 0.f, a2 = 0.f;
#pragma unroll 32
  for (int k = w * 256; k < w * 256 + 256; ++k) {
    float wv = wm[(size_t)k * 6144 + n];
    a0 += silu(c0[k]) * wv; a1 += silu(c1[k]) * wv; a2 += silu(c2[k]) * wv;
  }
  float* red = (float*)smem;
  __syncthreads();
  red[(w * 3 + 0) * 64 + lane] = a0; red[(w * 3 + 1) * 64 + lane] = a1; red[(w * 3 + 2) * 64 + lane] = a2;
  __syncthreads();
  if (tid < 192) {
    int cv = tid >> 6;
    float s = red[(0 * 3 + cv) * 64 + lane] + red[(1 * 3 + cv) * 64 + lane] + red[(2 * 3 + cv) * 64 + lane] + red[(3 * 3 + cv) * 64 + lane];
    float* mod = (float*)(p.ws + OFF_MOD);
    mod[(size_t)(l * 3 + cv) * 6144 + n] = s + p.in[8][l * 6144 + n];
  }
}
DI void rope_item(const Params& p, int it, int tid) {
  float* rc = (float*)(p.ws + OFF_ROPE);
#pragma unroll
  for (int j = 0; j < 8; ++j) {
    int idx = it * 2048 + tid * 8 + j;
    int pos = idx >> 5, i = idx & 31;
    float inv = exp2f(-(float)(i & 15) * (13.287712379549449f / 16.f));
    float ang = (float)(i < 16 ? (pos >> 6) : (pos & 63)) * inv;
    rc[idx] = cosf(ang); rc[131072 + idx] = sinf(ang);
  }
}
DI void misc_item(const Params& p, int tid) {
  if (tid < 64) {
    for (int l = 0; l < 2; ++l) {
      const float* lq = p.in[20] + l * 256;
      float a = lq[tid] * lq[64 + tid], b = lq[128 + tid] * lq[192 + tid];
      for (int o = 32; o > 0; o >>= 1) { a += __shfl_xor(a, o); b += __shfl_xor(b, o); }
      if (tid == 0) {
        float lam_init = 0.8f - 0.6f * expf(-0.3f * (float)l);
        ((float*)(p.ws + OFF_MISC))[l] = expf(a) - expf(b) + lam_init;
        ((float*)(p.ws + OFF_MISC))[2 + l] = 1.f - lam_init;
      }
    }
  }
}

DI void norm_item(const Params& p, int s, int l, int which, int it, int tid) {
  const int lane = tid & 63, w = tid >> 6;
  const int row = it * 4 + w;
  const float* x;
  if (which == 0 && l == 0) x = p.in[s] + (size_t)row * 1024;
  else x = p.out + ((size_t)s * TOK + row) * 1024;
  const int cv = s == 0 ? 0 : 1 + (row >> 12);
  const float* mod = (const float*)(p.ws + OFF_MOD) + (size_t)(l * 3 + cv) * 6144 + which * 3072;
  const float* g = p.in[which == 0 ? 9 : 10] + l * 1024;
  float4 v[4]; float ss = 0.f;
#pragma unroll
  for (int i = 0; i < 4; ++i) {
    v[i] = *(const float4*)(x + 4 * (lane + 64 * i));
    ss += v[i].x * v[i].x + v[i].y * v[i].y + v[i].z * v[i].z + v[i].w * v[i].w;
  }
  for (int o = 32; o > 0; o >>= 1) ss += __shfl_xor(ss, o);
  const float rn = rsqrtf(ss * (1.f / 1024.f) + 1e-6f);
  bf16_t* h = (bf16_t*)(p.ws + OFF_H) + (size_t)row * 1024;
#pragma unroll
  for (int i = 0; i < 4; ++i) {
    const int c = 4 * (lane + 64 * i);
    float4 gg = *(const float4*)(g + c), sh = *(const float4*)(mod + c), sc = *(const float4*)(mod + 1024 + c);
    float y0 = v[i].x * rn * gg.x * (1.f + sc.x) + sh.x;
    float y1 = v[i].y * rn * gg.y * (1.f + sc.y) + sh.y;
    float y2 = v[i].z * rn * gg.z * (1.f + sc.z) + sh.z;
    float y3 = v[i].w * rn * gg.w * (1.f + sc.w) + sh.w;
    uint2 o; o.x = pk2(y0, y1); o.y = pk2(y2, y3);
    *(uint2*)(h + c) = o;
  }
}

DI void gemm1_tile(const Params& p, int l, int t, char* smem, int tid) {
  const int nb = t & 63, mb = t >> 6;
  const int m0 = mb * 128, n0 = nb * 128;
  const bf16_t* A = (const bf16_t*)(p.ws + OFF_H);
  const bf16_t* B = (const bf16_t*)(p.ws + (size_t)l * WSET + OFF_WIN);
  bf16_t* sA = (bf16_t*)smem; bf16_t* sB = sA + 2 * GST;
  f32x16 acc[2][2];
  for (int a = 0; a < 2; ++a) for (int b = 0; b < 2; ++b) acc[a][b] = zero16();
  const int lr = tid >> 3, kc = (tid & 7) * 8;
  {
    const bf16_t* bp = B + (unsigned)((n0 + lr) * 1024 + kc);
    gemm_main<false>(acc, A + (unsigned)((m0 + lr) * 1024 + kc), (size_t)32 * 1024, bp, bp + 32 * 1024, bp + 64 * 1024, bp + 96 * 1024, 16, sA, sB, tid);
  }
  bf16_t* dst; int ld, c0;
  if (n0 < 1024)      { dst = (bf16_t*)(p.ws + OFF_SEGA); ld = 1024; c0 = n0; }
  else if (n0 < 3584) { dst = (bf16_t*)(p.ws + OFF_SEGH); ld = 2560; c0 = n0 - 1024; }
  else if (n0 < 5120) { dst = (bf16_t*)(p.ws + OFF_SEGC); ld = 1536; c0 = n0 - 3584; }
  else                { dst = (bf16_t*)(p.ws + OFF_SEGG); ld = 3072; c0 = n0 - 5120; }
  const int lane = tid & 63, w = tid >> 6, wm = w >> 1, wn = w & 1, r = lane & 31, hh = lane >> 5;
  bf16_t* Gs = (bf16_t*)smem;
#pragma unroll
  for (int mi = 0; mi < 2; ++mi)
#pragma unroll
    for (int ni = 0; ni < 2; ++ni)
#pragma unroll
      for (int i = 0; i < 16; ++i)
        Gs[(wm * 64 + mi * 32 + crow(i, hh)) * 136 + wn * 64 + ni * 32 + r] = f2bf(acc[mi][ni][i]);
  __syncthreads();
  {
    const int grow = tid >> 4, gc8 = (tid & 15) * 8;
#pragma unroll
    for (int i = 0; i < 8; ++i)
      *(u32x4*)(dst + (unsigned)((m0 + grow + 16 * i) * ld + c0 + gc8)) = *(const u32x4*)(Gs + (grow + 16 * i) * 136 + gc8);
  }
}

DI void branch_tile(const Params& p, int l, int t, char* smem, int tid) {
  const int nb = t & 7, mb = t >> 3;
  const int m0 = mb * 128, n0 = nb * 128;
  bf16_t* sA = (bf16_t*)smem; bf16_t* sB = sA + 2 * GST;
  bf16_t* Gs = (bf16_t*)smem;
  const bf16_t* B = (const bf16_t*)(p.ws + (size_t)l * WSET + OFF_WBR);
  const bf16_t* G = (const bf16_t*)(p.ws + OFF_SEGG);
  const int lr = tid >> 3, kc = (tid & 7) * 8;
  const int lane = tid & 63, w = tid >> 6, wm = w >> 1, wn = w & 1, r = lane & 31, hh = lane >> 5;
  const int grow = tid >> 4, gc8 = (tid & 15) * 8;
  f32x16 tot[2][2];
  for (int a = 0; a < 2; ++a) for (int b = 0; b < 2; ++b) tot[a][b] = zero16();
#pragma unroll 1
  for (int br = 0; br < 3; ++br) {
    const bf16_t* A = (const bf16_t*)(p.ws + (br == 0 ? OFF_ACTA : (br == 1 ? OFF_ACTB : OFF_OC)));
    u32x4 gq0, gq1, gq2, gq3, gq4, gq5, gq6, gq7;
    {
      const bf16_t* gp = G + (unsigned)((m0 + grow) * 3072 + br * 1024 + n0 + gc8);
      gq0 = *(const u32x4*)(gp);             gq1 = *(const u32x4*)(gp + 16 * 3072); gq2 = *(const u32x4*)(gp + 32 * 3072); gq3 = *(const u32x4*)(gp + 48 * 3072);
      gq4 = *(const u32x4*)(gp + 64 * 3072); gq5 = *(const u32x4*)(gp + 80 * 3072); gq6 = *(const u32x4*)(gp + 96 * 3072); gq7 = *(const u32x4*)(gp + 112 * 3072);
    }
    f32x16 acc[2][2];
    for (int a = 0; a < 2; ++a) for (int b = 0; b < 2; ++b) acc[a][b] = zero16();
    {
      const bf16_t* bp = B + (unsigned)((n0 + lr) * 1536 + br * 512 + kc);
      gemm_main<false>(acc, A + (unsigned)((m0 + lr) * 512 + kc), (size_t)32 * 512, bp, bp + 32 * 1536, bp + 64 * 1536, bp + 96 * 1536, 8, sA, sB, tid);
    }
    {
      bf16_t* gs = Gs + grow * 136 + gc8;
      *(u32x4*)(gs) = gq0;            *(u32x4*)(gs + 16 * 136) = gq1; *(u32x4*)(gs + 32 * 136) = gq2; *(u32x4*)(gs + 48 * 136) = gq3;
      *(u32x4*)(gs + 64 * 136) = gq4; *(u32x4*)(gs + 80 * 136) = gq5; *(u32x4*)(gs + 96 * 136) = gq6; *(u32x4*)(gs + 112 * 136) = gq7;
    }
    __syncthreads();
#pragma unroll
    for (int mi = 0; mi < 2; ++mi)
#pragma unroll
      for (int ni = 0; ni < 2; ++ni)
#pragma unroll
        for (int i = 0; i < 16; ++i) {
          const float gte = bf2f(Gs[(wm * 64 + mi * 32 + crow(i, hh)) * 136 + wn * 64 + ni * 32 + r]);
          tot[mi][ni][i] += sigm(gte) * acc[mi][ni][i];
        }
  }
  __syncthreads();
#pragma unroll
  for (int mi = 0; mi < 2; ++mi)
#pragma unroll
    for (int ni = 0; ni < 2; ++ni)
#pragma unroll
      for (int i = 0; i < 16; ++i)
        Gs[(wm * 64 + mi * 32 + crow(i, hh)) * 136 + wn * 64 + ni * 32 + r] = f2bf(tot[mi][ni][i]);
  __syncthreads();
  bf16_t* M = (bf16_t*)(p.ws + OFF_M);
#pragma unroll
  for (int i = 0; i < 8; ++i)
    *(u32x4*)(M + (unsigned)((m0 + grow + 16 * i) * 1024 + n0 + gc8)) = *(const u32x4*)(Gs + (grow + 16 * i) * 136 + gc8);
}

DI void resid_tile(const Params& p, int s, int l, int which, int t, char* smem, int tid) {
  const int nb = t & 7, mb = t >> 3;
  const int m0 = mb * 128, n0 = nb * 128;
  bf16_t* sA = (bf16_t*)smem; bf16_t* sB = sA + 2 * GST;
  const int K = which == 0 ? 1024 : DFF;
  const bf16_t* A = (const bf16_t*)(p.ws + (which == 0 ? OFF_M : OFF_FF));
  const bf16_t* B = (const bf16_t*)(p.ws + (size_t)l * WSET + (which == 0 ? OFF_WOUT : OFF_WFO));
  const int lr = tid >> 3, kc = (tid & 7) * 8;
  f32x16 acc[2][2];
  for (int a = 0; a < 2; ++a) for (int b = 0; b < 2; ++b) acc[a][b] = zero16();
  {
    const bf16_t* bp = B + (unsigned)((n0 + lr) * K + kc);
    gemm_main<false>(acc, A + (unsigned)((m0 + lr) * K + kc), (size_t)32 * K, bp, bp + (size_t)32 * K, bp + (size_t)64 * K, bp + (size_t)96 * K, K / 64, sA, sB, tid);
  }
  const int lane = tid & 63, w = tid >> 6, wm = w >> 1, wn = w & 1, r = lane & 31, hh = lane >> 5;
  const float* xin = (which == 0 && l == 0) ? p.in[s] : p.out + (size_t)s * TOK * 1024;
  float* xout = p.out + (size_t)s * TOK * 1024;
  const int cv = s == 0 ? 0 : 1 + (m0 >> 12);
  const float* modb = (const float*)(p.ws + OFF_MOD) + (size_t)(l * 3 + cv) * 6144 + (which == 0 ? 2048 : 5120);
  float* Fs = (float*)smem;
#pragma unroll
  for (int mi = 0; mi < 2; ++mi)
#pragma unroll
    for (int ni = 0; ni < 2; ++ni)
#pragma unroll
      for (int i = 0; i < 16; ++i)
        Fs[(wm * 64 + mi * 32 + crow(i, hh)) * 132 + wn * 64 + ni * 32 + r] = acc[mi][ni][i];
  __syncthreads();
  {
    const int frow = tid >> 5, fc4 = (tid & 31) * 4;
    const float4 gt = *(const float4*)(modb + n0 + fc4);
#pragma unroll
    for (int i = 0; i < 16; ++i) {
      const unsigned idx = (unsigned)((m0 + frow + 8 * i) * 1024 + n0 + fc4);
      const float4 a4 = *(const float4*)(Fs + (frow + 8 * i) * 132 + fc4);
      const float4 x4 = *(const float4*)(xin + idx);
      float4 o4; o4.x = x4.x + gt.x * a4.x; o4.y = x4.y + gt.y * a4.y; o4.z = x4.z + gt.z * a4.z; o4.w = x4.w + gt.w * a4.w;
      *(float4*)(xout + idx) = o4;
    }
  }
}

DI void ffnin_tile(const Params& p, int l, int t, char* smem, int tid) {
  const int nb = t % 44, mb = t / 44;
  const int m0 = mb * 128, j0 = nb * 64;
  bf16_t* sA = (bf16_t*)smem; bf16_t* sB = sA + 2 * GST;
  const bf16_t* A = (const bf16_t*)(p.ws + OFF_H);
  const bf16_t* B = (const bf16_t*)(p.ws + (size_t)l * WSET + OFF_WFI);
  const int lr = tid >> 3, kc = (tid & 7) * 8;
  f32x16 acc[2][2];
  for (int a = 0; a < 2; ++a) for (int b = 0; b < 2; ++b) acc[a][b] = zero16();
  {
    const bf16_t* bp = B + (unsigned)((j0 + lr) * 1024 + kc);
    gemm_main<false>(acc, A + (unsigned)((m0 + lr) * 1024 + kc), (size_t)32 * 1024, bp, bp + (size_t)DFF * 1024, bp + (size_t)32 * 1024, bp + (size_t)(DFF + 32) * 1024,
              16, sA, sB, tid);
  }
  const int lane = tid & 63, w = tid >> 6, wm = w >> 1, wn = w & 1, r = lane & 31, hh = lane >> 5;
  bf16_t* FF = (bf16_t*)(p.ws + OFF_FF);
  bf16_t* Gs = (bf16_t*)smem;
#pragma unroll
  for (int mi = 0; mi < 2; ++mi)
#pragma unroll
    for (int i = 0; i < 16; ++i)
      Gs[(wm * 64 + mi * 32 + crow(i, hh)) * 72 + 32 * wn + r] = f2bf(silu(acc[mi][0][i]) * acc[mi][1][i]);
  __syncthreads();
  {
    const int grow = tid >> 3, gc8 = (tid & 7) * 8;
#pragma unroll
    for (int i = 0; i < 4; ++i)
      *(u32x4*)(FF + (unsigned)((m0 + grow + 32 * i) * DFF + j0 + gc8)) = *(const u32x4*)(Gs + (grow + 32 * i) * 72 + gc8);
  }
}

DI void conv_item(const Params& p, int s, int l, int it, char* smem, int tid) {
  const int ntok = s == 0 ? 256 : 4096;
  const int tile0 = it * 16;
  const int seq0 = tile0 & ~(ntok - 1);
  const int n0 = tile0 - seq0;
  const bf16_t* SA = (const bf16_t*)(p.ws + OFF_SEGA);
  const float* cw = p.in[12] + (size_t)l * 31 * 512;
  bf16_t* As = (bf16_t*)smem;
  float* Cs = (float*)smem;
  __syncthreads();
#pragma unroll 4
  for (int id = tid; id < 46 * 64; id += 256) {
    const int rr = id >> 6, c8 = (id & 63) * 8;
    const int n = n0 - 15 + rr;
    u32x4 o = {0u, 0u, 0u, 0u};
    if (n >= 0 && n < ntok) {
      const bf16_t* rp = SA + (size_t)(seq0 + n) * 1024 + c8;
      const u32x4 vv = *(const u32x4*)rp, gg = *(const u32x4*)(rp + 512);
#pragma unroll
      for (int j = 0; j < 4; ++j) o[j] = pk2(bflo(vv[j]) * sigm(bflo(gg[j])), bfhi(vv[j]) * sigm(bfhi(gg[j])));
    }
    *(u32x4*)(As + rr * 520 + c8) = o;
  }
  __syncthreads();
  float acc0[16], acc1[16];
  {
    float w0[31], w1[31];
#pragma unroll
    for (int j = 0; j < 31; ++j) { float2 t2 = *(const float2*)(cw + j * 512 + 2 * tid); w0[j] = t2.x; w1[j] = t2.y; }
    const float2 cb = *(const float2*)(p.in[13] + l * 512 + 2 * tid);
#pragma unroll
    for (int t = 0; t < 16; ++t) { acc0[t] = cb.x; acc1[t] = cb.y; }
#pragma unroll
    for (int rr = 0; rr < 46; ++rr) {
      const unsigned av = *(const unsigned*)(As + rr * 520 + 2 * tid);
      const float a0 = bflo(av), a1 = bfhi(av);
#pragma unroll
      for (int t = 0; t < 16; ++t) {
        const int j = rr - t;
        if (j >= 0 && j <= 30) { acc0[t] += a0 * w0[j]; acc1[t] += a1 * w1[j]; }
      }
    }
  }
  __syncthreads();
#pragma unroll
  for (int t = 0; t < 16; ++t) { float2 o; o.x = acc0[t]; o.y = acc1[t]; *(float2*)(Cs + t * 516 + 2 * tid) = o; }
  __syncthreads();
  const int lane = tid & 63, w = tid >> 6;
  const float* lg = p.in[14] + l * 512 + lane * 8;
  const float* lb = p.in[15] + l * 512 + lane * 8;
  bf16_t* AA = (bf16_t*)(p.ws + OFF_ACTA);
#pragma unroll
  for (int tt = 0; tt < 4; ++tt) {
    const int t = w * 4 + tt;
    float x[8];
    float4 xa = *(const float4*)(Cs + t * 516 + lane * 8), xb = *(const float4*)(Cs + t * 516 + lane * 8 + 4);
    x[0] = xa.x; x[1] = xa.y; x[2] = xa.z; x[3] = xa.w; x[4] = xb.x; x[5] = xb.y; x[6] = xb.z; x[7] = xb.w;
    float sm = 0.f;
    for (int j = 0; j < 8; ++j) sm += x[j];
    for (int o = 32; o > 0; o >>= 1) sm += __shfl_xor(sm, o);
    const float mu = sm * (1.f / 512.f);
    float vs = 0.f;
    for (int j = 0; j < 8; ++j) { x[j] -= mu; vs += x[j] * x[j]; }
    for (int o = 32; o > 0; o >>= 1) vs += __shfl_xor(vs, o);
    const float rn = rsqrtf(vs * (1.f / 512.f) + 1e-5f);
    float y[8];
    for (int j = 0; j < 8; ++j) y[j] = silu(x[j] * rn * lg[j] + lb[j]);
    *(bf16x8*)(AA + (size_t)(tile0 + t) * 512 + lane * 8) = pack8(y[0], y[1], y[2], y[3], y[4], y[5], y[6], y[7]);
  }
}

DI void qkprep_item(const Params& p, int s, int l, int it, char* smem, int tid) {
  const int lane = tid & 63, w = tid >> 6;
  const bool ctx = it >= 128;
  const int ntok = s == 0 ? 256 : 4096;
  const int M = s == 0 ? 256 : 4352;
  const int coff = s == 0 ? 0 : 256;
  int b, npos0, tok0;
  if (!ctx) { tok0 = it * 64; b = tok0 / ntok; npos0 = coff + (tok0 - b * ntok); }
  else { b = (it - 128) >> 2; tok0 = 0; npos0 = ((it - 128) & 3) * 64; }
  const bf16_t* SC = (const bf16_t*)(p.ws + OFF_SEGC);
  bf16_t* QN = (bf16_t*)(p.ws + OFF_QN);
  bf16_t* KB = (bf16_t*)(p.ws + OFF_KB);
  bf16_t* VT = (bf16_t*)(p.ws + OFF_VT);
  const float* rope = (const float*)(p.ws + OFF_ROPE);
  const int g = lane >> 3, sub = lane & 7;
#pragma unroll 4
  for (int task = w; task < 128; task += 4) {
    const int which = task >> 6, tl = task & 63;
    if (ctx && which == 0) continue;
    float x[8];
    if (!ctx) {
      uint4 raw = *(const uint4*)(SC + (size_t)(tok0 + tl) * 1536 + which * 512 + g * 64 + sub * 8);
      x[0] = bflo(raw.x); x[1] = bfhi(raw.x); x[2] = bflo(raw.y); x[3] = bfhi(raw.y);
      x[4] = bflo(raw.z); x[5] = bfhi(raw.z); x[6] = bflo(raw.w); x[7] = bfhi(raw.w);
      float ss = 0.f;
      for (int j = 0; j < 8; ++j) ss += x[j] * x[j];
      ss += __shfl_xor(ss, 1); ss += __shfl_xor(ss, 2); ss += __shfl_xor(ss, 4);
      const float rn = rsqrtf(ss * (1.f / 64.f) + 1e-6f);
      const float* nw = p.in[which == 0 ? 18 : 19] + l * 64 + sub * 8;
      for (int j = 0; j < 8; ++j) x[j] = x[j] * rn * nw[j];
      if (s == 1) {
        const int pos = (tok0 + tl) & 4095;
        float4 cc = *(const float4*)(rope + pos * 32 + sub * 4), sn = *(const float4*)(rope + 131072 + pos * 32 + sub * 4);
        float c4[4] = {cc.x, cc.y, cc.z, cc.w}, s4[4] = {sn.x, sn.y, sn.z, sn.w};
        for (int q = 0; q < 4; ++q) {
          float x1 = x[2 * q], x2 = x[2 * q + 1];
          x[2 * q] = x1 * c4[q] - x2 * s4[q]; x[2 * q + 1] = x1 * s4[q] + x2 * c4[q];
        }
      }
    } else {
      const float* ck = p.in[2] + ((size_t)(b * 2 + l) * 256 + npos0 + tl) * 512 + g * 64 + sub * 8;
      float4 xa = *(const float4*)ck, xb = *(const float4*)(ck + 4);
      x[0] = xa.x; x[1] = xa.y; x[2] = xa.z; x[3] = xa.w; x[4] = xb.x; x[5] = xb.y; x[6] = xb.z; x[7] = xb.w;
    }
    if (which == 0) {
      *(bf16x8*)(QN + (size_t)(tok0 + tl) * 512 + g * 64 + sub * 8) =
          pack8(x[0] * QSCALE, x[1] * QSCALE, x[2] * QSCALE, x[3] * QSCALE, x[4] * QSCALE, x[5] * QSCALE, x[6] * QSCALE, x[7] * QSCALE);
    } else {
      *(bf16x8*)(KB + ((size_t)(b * 8 + g) * M + npos0 + tl) * 64 + sub * 8) = pack8(x[0], x[1], x[2], x[3], x[4], x[5], x[6], x[7]);
      if (s == 0) {
        float* ok = p.out + OUT_CK + ((size_t)(b * 2 + l) * 256 + (npos0 + tl)) * 512 + g * 64 + sub * 8;
        float4 oa = {x[0], x[1], x[2], x[3]}, ob = {x[4], x[5], x[6], x[7]};
        *(float4*)ok = oa; *(float4*)(ok + 4) = ob;
      }
    }
  }
  bf16_t* Vs = (bf16_t*)smem;
  for (int hd = 0; hd < 4; ++hd) {
    __syncthreads();
#pragma unroll
    for (int i = 0; i < 4; ++i) {
      const int id = tid + 256 * i;
      const int tl = id >> 4, ch = id & 15;
      uint4 raw;
      if (!ctx) {
        raw = *(const uint4*)(SC + (size_t)(tok0 + tl) * 1536 + 1024 + hd * 128 + ch * 8);
        if (s == 0) {
          float* ov = p.out + OUT_CV + ((size_t)(b * 2 + l) * 256 + (npos0 + tl)) * 512 + hd * 128 + ch * 8;
          float4 oa = {bflo(raw.x), bfhi(raw.x), bflo(raw.y), bfhi(raw.y)}, ob = {bflo(raw.z), bfhi(raw.z), bflo(raw.w), bfhi(raw.w)};
          *(float4*)ov = oa; *(float4*)(ov + 4) = ob;
        }
      } else {
        const float* cvp = p.in[3] + ((size_t)(b * 2 + l) * 256 + npos0 + tl) * 512 + hd * 128 + ch * 8;
        float4 xa = *(const float4*)cvp, xb = *(const float4*)(cvp + 4);
        raw.x = pk2(xa.x, xa.y); raw.y = pk2(xa.z, xa.w); raw.z = pk2(xb.x, xb.y); raw.w = pk2(xb.z, xb.w);
      }
      *(uint4*)(Vs + tl * 136 + ch * 8) = raw;
    }
    __syncthreads();
    const int e = tid & 127, half = tid >> 7;
    bf16_t* dstp = VT + ((size_t)(b * 4 + hd) * 128 + e) * M + npos0 + 32 * half;
#pragma unroll
    for (int q = 0; q < 4; ++q) {
      unsigned u[4];
#pragma unroll
      for (int j = 0; j < 4; ++j) {
        unsigned lo = Vs[(32 * half + 8 * q + 2 * j) * 136 + e], hi = Vs[(32 * half + 8 * q + 2 * j + 1) * 136 + e];
        u[j] = lo | (hi << 16);
      }
      uint4 o; o.x = u[0]; o.y = u[1]; o.z = u[2]; o.w = u[3];
      *(uint4*)(dstp + 8 * q) = o;
    }
  }
}

DI void attn_item(const Params& p, int s, int l, int it, char* smem, int tid) {
  const int lane = tid & 63, w = tid >> 6, r = lane & 31, hh = lane >> 5;
  const int c = w >> 1, qsub = w & 1;
  const int ntok = s == 0 ? 256 : 4096;
  const int M = s == 0 ? 256 : 4352;
  const int qbs = ntok >> 6;
  const int qb = it % qbs, bh = it / qbs;
  const int b = bh >> 2, h = bh & 3;
  const int tq = b * ntok + qb * 64 + qsub * 32 + r;
  const bf16_t* QN = (const bf16_t*)(p.ws + OFF_QN);
  const bf16_t* Kg = (const bf16_t*)(p.ws + OFF_KB) + (size_t)bh * 2 * M * 64;
  const bf16_t* Vg = (const bf16_t*)(p.ws + OFF_VT) + (size_t)bh * 128 * M;
  bf16_t* Ks = (bf16_t*)smem;
  bf16x8 bq[4];
#pragma unroll
  for (int ks = 0; ks < 4; ++ks) bq[ks] = *(const bf16x8*)(QN + (size_t)tq * 512 + h * 128 + c * 64 + ks * 16 + hh * 8);
  f32x16 O[4];
  for (int e = 0; e < 4; ++e) O[e] = zero16();
  float mrun = -INFINITY, lrun = 0.f;
  const int nt = M >> 6;
  uint4 rk0, rk1, rk2, rk3, rv0, rv1, rv2, rv3;
  const int ch8 = (tid & 7) * 8;
  const bf16_t* kp0 = Kg + (size_t)((tid >> 3) & 63) * 64 + ch8;
  const bf16_t* kp1 = kp0 + (size_t)M * 64;
  const bf16_t* vp = Vg + (size_t)(tid >> 3) * M + ch8;
#define GLOAD(KT) { \
    rk0 = *(const uint4*)(kp0 + (size_t)(KT) * 4096); rk1 = *(const uint4*)(kp0 + (size_t)(KT) * 4096 + 2048); \
    rk2 = *(const uint4*)(kp1 + (size_t)(KT) * 4096); rk3 = *(const uint4*)(kp1 + (size_t)(KT) * 4096 + 2048); \
    rv0 = *(const uint4*)(vp + (KT) * 64); rv1 = *(const uint4*)(vp + (size_t)32 * M + (KT) * 64); \
    rv2 = *(const uint4*)(vp + (size_t)64 * M + (KT) * 64); rv3 = *(const uint4*)(vp + (size_t)96 * M + (KT) * 64); }
#define VSTORE(E, RV) { uint2 lo_, hi_; lo_.x = RV.x; lo_.y = RV.y; hi_.x = RV.z; hi_.y = RV.w; \
    *(uint2*)(Vs + (E) * 68 + ch8) = lo_; *(uint2*)(Vs + (E) * 68 + ch8 + 4) = hi_; }
  constexpr int AST = 2 * 64 * 72 + 128 * 68;
#define ASTORE(ST) { bf16_t* Kw = Ks + (ST) * AST; bf16_t* Vs = Kw + 2 * 64 * 72; const int key = (tid >> 3) & 63, e = tid >> 3; \
      *(uint4*)(Kw + (key) * 72 + ch8) = rk0; *(uint4*)(Kw + (32 + key) * 72 + ch8) = rk1; \
      *(uint4*)(Kw + (64 + key) * 72 + ch8) = rk2; *(uint4*)(Kw + (96 + key) * 72 + ch8) = rk3; \
      VSTORE(e, rv0); VSTORE(e + 32, rv1); VSTORE(e + 64, rv2); VSTORE(e + 96, rv3); }
  GLOAD(0);
  __syncthreads();
  ASTORE(0);
  if (nt > 1) GLOAD(1);
  __syncthreads();
  for (int kt = 0; kt < nt; ++kt) {
    const bf16_t* Kc = Ks + (kt & 1) * AST;
    const bf16_t* Vc = Kc + 2 * 64 * 72;
    f32x16 S[2];
    const float negm = kt == 0 ? 0.f : -mrun;
    __builtin_amdgcn_s_setprio(1);
#pragma unroll
    for (int kk = 0; kk < 2; ++kk) {
#pragma unroll
      for (int i = 0; i < 16; ++i) S[kk][i] = negm;
#pragma unroll
      for (int ks = 0; ks < 4; ++ks) {
        bf16x8 ka = *(const bf16x8*)(Kc + (c * 64 + kk * 32 + r) * 72 + ks * 16 + hh * 8);
        S[kk] = MFMA(ka, bq[ks], S[kk]);
      }
    }
    __builtin_amdgcn_s_setprio(0);
    float mx = S[0][0];
#pragma unroll
    for (int i = 0; i < 16; ++i) { mx = fmaxf(mx, S[0][i]); mx = fmaxf(mx, S[1][i]); }
    mx = fmaxf(mx, __shfl_xor(mx, 32));
    if (__builtin_amdgcn_ballot_w64(kt == 0 || mx > 8.f) != 0ull) {
      const float dm = fmaxf(mx, 0.f);
      const float mold = kt == 0 ? 0.f : mrun;
      const float mnew = kt == 0 ? mx : mold + dm;
      const float shift = mnew - mold;
      const float alpha = kt == 0 ? 0.f : __builtin_amdgcn_exp2f(-shift);
      mrun = mnew;
      lrun *= alpha;
#pragma unroll
      for (int e = 0; e < 4; ++e)
#pragma unroll
        for (int i = 0; i < 16; ++i) O[e][i] *= alpha;
#pragma unroll
      for (int i = 0; i < 16; ++i) { S[0][i] -= shift; S[1][i] -= shift; }
    }
    f32x2 ps2 = {0.f, 0.f};
#pragma unroll
    for (int i = 0; i < 16; ++i) {
      S[0][i] = __builtin_amdgcn_exp2f(S[0][i]); S[1][i] = __builtin_amdgcn_exp2f(S[1][i]);
      f32x2 t2 = {S[0][i], S[1][i]};
      ps2 += t2;
    }
    lrun += ps2[0] + ps2[1];
    bf16x8 pb[2][2];
    pb[0][0] = PACK_STEP(S[0], 0); pb[0][1] = PACK_STEP(S[0], 1); pb[1][0] = PACK_STEP(S[1], 0); pb[1][1] = PACK_STEP(S[1], 1);
    __builtin_amdgcn_s_setprio(1);
#pragma unroll
    for (int e = 0; e < 4; ++e)
#pragma unroll
      for (int kk = 0; kk < 2; ++kk)
#pragma unroll
        for (int s2 = 0; s2 < 2; ++s2) {
          bf16x8 va = ld_perm(Vc + (e * 32 + r) * 68 + kk * 32 + 16 * s2 + 4 * hh);
          O[e] = MFMA(va, pb[kk][s2], O[e]);
        }
    __builtin_amdgcn_s_setprio(0);
    __builtin_amdgcn_sched_barrier(0);
    if (kt + 1 < nt) {
      ASTORE((kt + 1) & 1);
      if (kt + 2 < nt) GLOAD(kt + 2);
    }
    __syncthreads();
  }
  const float ltot = lrun + __shfl_xor(lrun, 32);
  const float inv = 1.f / ltot;
  float* Xs = (float*)smem;
  __syncthreads();
  if (c == 1) {
#pragma unroll
    for (int e = 0; e < 4; ++e)
#pragma unroll
      for (int i = 0; i < 16; ++i) Xs[(qsub * 64 + e * 16 + i) * 64 + lane] = O[e][i] * inv;
  }
  __syncthreads();
  if (c == 0) {
    const float lam = ((const float*)(p.ws + OFF_MISC))[l];
    float ss = 0.f;
#pragma unroll
    for (int e = 0; e < 4; ++e)
#pragma unroll
      for (int i = 0; i < 16; ++i) {
        float v = O[e][i] * inv - lam * Xs[(qsub * 64 + e * 16 + i) * 64 + lane];
        O[e][i] = v; ss += v * v;
      }
    ss += __shfl_xor(ss, 32);
    const float rn = rsqrtf(ss * (1.f / 128.f) + 1e-6f) * ((const float*)(p.ws + OFF_MISC))[2 + l];
    const float* sl = p.in[21] + l * 128;
    bf16_t* OC = (bf16_t*)(p.ws + OFF_OC) + (size_t)tq * 512 + h * 128;
#pragma unroll
    for (int e = 0; e < 4; ++e)
#pragma unroll
      for (int g4 = 0; g4 < 4; ++g4) {
        const int e0 = e * 32 + 8 * g4 + 4 * hh;
        float4 sw = *(const float4*)(sl + e0);
        uint2 o;
        o.x = pk2(O[e][4 * g4 + 0] * rn * sw.x, O[e][4 * g4 + 1] * rn * sw.y);
        o.y = pk2(O[e][4 * g4 + 2] * rn * sw.z, O[e][4 * g4 + 3] * rn * sw.w);
        *(uint2*)(OC + e0) = o;
      }
  }
}

struct HgrnSmem {
  bf16_t Qs[32 * 136]; bf16_t Ks[32 * 136]; bf16_t KTs[128 * 40]; bf16_t VTs[128 * 40];
  float ebs[128]; float tot[2][128];
  bf16_t raw[3 * 4096];
};
struct HgrnPref { u32x4 z0, z1, q0, q1, v0, v1; };

template <int OUT>
DI void hgrn_prefetch(HgrnPref& pf, const bf16_t* SH, int tk0, int h, int dir, int tid) {
  const bf16_t* g = SH + (size_t)(tk0 + (tid >> 4)) * 2560 + h * 128 + (tid & 15) * 8;
  pf.z0 = *(const u32x4*)(g + 1024 + dir * 512); pf.z1 = *(const u32x4*)(g + 16 * 2560 + 1024 + dir * 512);
  pf.v0 = *(const u32x4*)(g + 512);              pf.v1 = *(const u32x4*)(g + 16 * 2560 + 512);
  if (OUT != 0) { pf.q0 = *(const u32x4*)(g);    pf.q1 = *(const u32x4*)(g + 16 * 2560); }
}

template <int OUT>
DI float hgrn_chunk(const Params& p, HgrnSmem& sm, int l, int tk0, int tkn, int h, int dir, float lbv, f32x16 (&S)[4], HgrnPref& pf, int tid_in) {
  int tid = tid_in;
  asm volatile("" : "+v"(tid));
  int lane = tid & 63, w = tid >> 6, r = lane & 31, hh = lane >> 5;
  int d = tid & 127, half = tid >> 7;
#define REDERIVE { asm volatile("" : "+v"(tid)); lane = tid & 63; w = tid >> 6; r = lane & 31; hh = lane >> 5; d = tid & 127; half = tid >> 7; }
  const bf16_t* SH = (const bf16_t*)(p.ws + OFF_SEGH);
  {
    const int ro = (tid >> 4) * 128 + (tid & 15) * 8;
    *(u32x4*)(sm.raw + ro) = pf.z0; *(u32x4*)(sm.raw + ro + 16 * 128) = pf.z1;
    *(u32x4*)(sm.raw + 8192 + ro) = pf.v0; *(u32x4*)(sm.raw + 8192 + ro + 16 * 128) = pf.v1;
    if (OUT != 0) { *(u32x4*)(sm.raw + 4096 + ro) = pf.q0; *(u32x4*)(sm.raw + 4096 + ro + 16 * 128) = pf.q1; }
  }
  if (tkn >= 0) hgrn_prefetch<OUT>(pf, SH, tkn, h, dir, tid);
  __syncthreads();
  float lf[16], kg[16];
#pragma unroll
  for (int i = 0; i < 16; ++i) {
    const float z = bf2f(sm.raw[(16 * half + i) * 128 + d]);
    const float e = __expf(-z);
    const float sg = 1.f / (1.f + e);
    const float f = lbv + (1.f - lbv) * sg;
    kg[i] = (1.f - lbv) * e * sg;
    lf[i] = __logf(f);
  }
  float run = 0.f;
  if (dir == 0) {
#pragma unroll
    for (int i = 0; i < 16; ++i) { run += lf[i]; lf[i] = run; }
  } else {
#pragma unroll
    for (int i = 15; i >= 0; --i) { run += lf[i]; lf[i] = run; }
  }
  sm.tot[half][d] = run;
  __syncthreads();
  REDERIVE
  const float t0 = sm.tot[0][d], t1 = sm.tot[1][d];
  const float off = dir == 0 ? (half ? t0 : 0.f) : (half ? 0.f : t1);
  if (half == 0) sm.ebs[d] = __expf(t0 + t1);
#pragma unroll
  for (int g8 = 0; g8 < 2; ++g8) {
    float kt[8], vv[8];
#pragma unroll
    for (int i = 0; i < 8; ++i) {
      const int tl = 16 * half + 8 * g8 + i;
      vv[i] = bf2f(sm.raw[8192 + tl * 128 + d]);
      const float bb = lf[8 * g8 + i] + off;
      kt[i] = kg[8 * g8 + i] * __expf(-bb);
      sm.Ks[tl * 136 + d] = f2bf(kt[i]);
      if (OUT != 0) {
        const float qv = bf2f(sm.raw[4096 + tl * 128 + d]);
        sm.Qs[tl * 136 + d] = f2bf(silu(qv) * __expf(bb));
      }
    }
    *(bf16x8*)(sm.KTs + d * 40 + 16 * half + 8 * g8) = pack8(kt[0], kt[1], kt[2], kt[3], kt[4], kt[5], kt[6], kt[7]);
    *(bf16x8*)(sm.VTs + d * 40 + 16 * half + 8 * g8) = pack8(vv[0], vv[1], vv[2], vv[3], vv[4], vv[5], vv[6], vv[7]);
  }
  __syncthreads();
  REDERIVE
  if (OUT != 0) {
    float* OSC = (float*)(p.ws + OFF_OSC);
    __builtin_amdgcn_s_setprio(1);
    f32x16 at = zero16(), at1 = zero16();
#pragma unroll
    for (int ks = 0; ks < 8; ks += 2) {
      bf16x8 ka = *(const bf16x8*)(sm.Ks + r * 136 + ks * 16 + hh * 8);
      bf16x8 qb = *(const bf16x8*)(sm.Qs + r * 136 + ks * 16 + hh * 8);
      at = MFMA(ka, qb, at);
      bf16x8 ka1 = *(const bf16x8*)(sm.Ks + r * 136 + ks * 16 + 16 + hh * 8);
      bf16x8 qb1 = *(const bf16x8*)(sm.Qs + r * 136 + ks * 16 + 16 + hh * 8);
      at1 = MFMA(ka1, qb1, at1);
    }
#pragma unroll
    for (int i = 0; i < 16; ++i) {
      const int srow = crow(i, hh);
      const bool keep = dir == 0 ? (srow <= r) : (srow >= r);
      at[i] = keep ? at[i] + at1[i] : 0.f;
    }
    __builtin_amdgcn_sched_barrier(0);
    f32x16 o = zero16();
#pragma unroll
    for (int s2 = 0; s2 < 2; ++s2) {
      bf16x8 pa = s2 == 0 ? PACK_STEP(at, 0) : PACK_STEP(at, 1);
      bf16x8 vf = ld_perm(sm.VTs + (32 * w + r) * 40 + 16 * s2 + 4 * hh);
      o = MFMA(pa, vf, o);
    }
    __builtin_amdgcn_sched_barrier(0);
    f32x16 o1 = zero16();
#pragma unroll
    for (int dt = 0; dt < 4; ++dt) {
      {
        bf16x8 qa = ld_perm(sm.Qs + r * 136 + 32 * dt + 4 * hh);
        bf16x8 sb = PACK_STEP(S[dt], 0);
        o = MFMA(qa, sb, o);
      }
      {
        bf16x8 qa = ld_perm(sm.Qs + r * 136 + 32 * dt + 16 + 4 * hh);
        bf16x8 sb = PACK_STEP(S[dt], 1);
        o1 = MFMA(qa, sb, o1);
      }
    }
#pragma unroll
    for (int i = 0; i < 16; ++i) o[i] += o1[i];
    __builtin_amdgcn_sched_barrier(0);
    if (OUT == 1) {
#pragma unroll
      for (int i = 0; i < 16; ++i) OSC[(size_t)(tk0 + crow(i, hh)) * 512 + h * 128 + 32 * w + r] = o[i];
    } else {
      bf16_t* OSB = (bf16_t*)(p.ws + OFF_OSB);
#pragma unroll
      for (int i = 0; i < 16; ++i) OSB[(size_t)(tk0 + crow(i, hh)) * 512 + h * 128 + 32 * w + r] = f2bf(o[i]);
    }
  }
  __builtin_amdgcn_sched_barrier(0);
  __builtin_amdgcn_s_setprio(1);
  REDERIVE
#pragma unroll
  for (int dt = 0; dt < 4; ++dt) {
#pragma unroll
    for (int ks = 0; ks < 2; ++ks) {
      bf16x8 ka = *(const bf16x8*)(sm.KTs + (32 * dt + r) * 40 + 16 * ks + 8 * hh);
      bf16x8 vb = *(const bf16x8*)(sm.VTs + (32 * w + r) * 40 + 16 * ks + 8 * hh);
      S[dt] = MFMA(ka, vb, S[dt]);
    }
#pragma unroll
    for (int g4 = 0; g4 < 4; ++g4) {
      float4 e4 = *(const float4*)(sm.ebs + 32 * dt + 8 * g4 + 4 * hh);
      S[dt][4 * g4 + 0] *= e4.x; S[dt][4 * g4 + 1] *= e4.y; S[dt][4 * g4 + 2] *= e4.z; S[dt][4 * g4 + 3] *= e4.w;
    }
  }
  __builtin_amdgcn_s_setprio(0);
  return t0 + t1;
}

DI void state_load(f32x16 (&S)[4], const float* base, int w, int r, int hh) {
  const float* q = base + (4 * hh) * 128 + 32 * w + r;
#pragma unroll
  for (int dt = 0; dt < 4; ++dt)
#pragma unroll
    for (int g4 = 0; g4 < 4; ++g4) {
#pragma unroll
      for (int j = 0; j < 4; ++j) S[dt][4 * g4 + j] = q[j * 128];
      q += 1024;
      asm volatile("" : "+v"(q));
    }
}
DI void state_store(const f32x16 (&S)[4], float* base, int w, int r, int hh) {
  float* q = base + (4 * hh) * 128 + 32 * w + r;
#pragma unroll
  for (int dt = 0; dt < 4; ++dt)
#pragma unroll
    for (int g4 = 0; g4 < 4; ++g4) {
#pragma unroll
      for (int j = 0; j < 4; ++j) q[j * 128] = S[dt][4 * g4 + j];
      q += 1024;
      asm volatile("" : "+v"(q));
    }
}
DI void state_scan(f32x16 (&S)[4], const float* base, const float* ebs, int w, int r, int hh) {
  const float* q = base + (4 * hh) * 128 + 32 * w + r;
#pragma unroll
  for (int dt = 0; dt < 4; ++dt) {
    __builtin_amdgcn_sched_barrier(0);
#pragma unroll
    for (int g4 = 0; g4 < 4; ++g4) {
      float4 e4 = *(const float4*)(ebs + 32 * dt + 8 * g4 + 4 * hh);
      S[dt][4 * g4 + 0] = e4.x * S[dt][4 * g4 + 0] + q[0];
      S[dt][4 * g4 + 1] = e4.y * S[dt][4 * g4 + 1] + q[128];
      S[dt][4 * g4 + 2] = e4.z * S[dt][4 * g4 + 2] + q[256];
      S[dt][4 * g4 + 3] = e4.w * S[dt][4 * g4 + 3] + q[384];
      q += 1024;
      asm volatile("" : "+v"(q));
    }
  }
}

DI float hgrn_lb(const Params& p, int l, int dir, int ch) {
  if (l == 0) return 0.f;
  const float* lb = p.in[16];
  float a = lb[(0 * 2 + dir) * 512 + ch], b = lb[(1 * 2 + dir) * 512 + ch];
  return 1.f / (1.f + __expf(a - b));
}

DI void hgrn_pass1_item(const Params& p, int l, int it, char* smem, int tid) {
  HgrnSmem& sm = *(HgrnSmem*)smem;
  const int j = it & 15, dir = (it >> 4) & 1, h = (it >> 5) & 3, b = it >> 7;
  const int lane = tid & 63, w = tid >> 6, r = lane & 31, hh = lane >> 5;
  const int d = tid & 127;
  const bf16_t* SH = (const bf16_t*)(p.ws + OFF_SEGH);
  const float lbv = hgrn_lb(p, l, dir, h * 128 + d);
  f32x16 S[4];
  for (int i = 0; i < 4; ++i) S[i] = zero16();
  float bt = 0.f;
  const int base = b * 4096 + j * 256;
  HgrnPref pf = {};
  hgrn_prefetch<0>(pf, SH, base + (dir == 0 ? 0 : 7) * 32, h, dir, tid);
  __syncthreads();
#pragma unroll 1
  for (int cc = 0; cc < 8; ++cc) {
    const int c = dir == 0 ? cc : 7 - cc;
    const int cn = dir == 0 ? c + 1 : c - 1;
    bt += hgrn_chunk<0>(p, sm, l, base + c * 32, cc < 7 ? base + cn * 32 : -1, h, dir, lbv, S, pf, tid);
  }
  state_store(S, (float*)(p.ws + OFF_SLOC) + (size_t)it * 16384, w, r, hh);
  if (tid < 128) ((float*)(p.ws + OFF_BTOT))[(size_t)it * 128 + d] = bt;
}

DI void hgrn_pass2_item(const Params& p, int s, int l, int it, char* smem, int tid_in) {
  HgrnSmem& sm = *(HgrnSmem*)smem;
  int tid = tid_in;
  asm volatile("" : "+v"(tid));
  const int nj = s == 0 ? 1 : 16;
  const int ntok = s == 0 ? 256 : 4096;
  const int dir = it & 1, it2 = it >> 1;
  const int j = it2 % nj, bh = it2 / nj, h = bh & 3, b = bh >> 2;
  int lane = tid & 63, w = tid >> 6, r = lane & 31, hh = lane >> 5;
  int d = tid & 127;
#define REDERIVE2 { asm volatile("" : "+v"(tid)); lane = tid & 63; w = tid >> 6; r = lane & 31; hh = lane >> 5; d = tid & 127; }
  const bf16_t* SH = (const bf16_t*)(p.ws + OFF_SEGH);
  const float* SLb = (const float*)(p.ws + OFF_SLOC);
  const float* BTb = (const float*)(p.ws + OFF_BTOT);
  const int base = b * ntok + j * 256;
  const float lbv = hgrn_lb(p, l, dir, h * 128 + d);
  HgrnPref pf = {};
  if (dir == 0) hgrn_prefetch<1>(pf, SH, base, h, 0, tid);
  else          hgrn_prefetch<2>(pf, SH, base + 7 * 32, h, 1, tid);
  f32x16 S[4];
  __syncthreads();
  if (s == 0) { for (int i = 0; i < 4; ++i) S[i] = zero16(); }
  else {
    state_load(S, p.in[4] + (size_t)(((b * 2 + l) * 2 + dir) * 4 + h) * 16384, w, r, hh);
    const int nsteps = dir == 0 ? j : 15 - j;
    float* ebt = (float*)sm.raw;
    for (int q = tid; q < nsteps * 128; q += 256) {
      const int st = q >> 7, dd = q & 127;
      const int jj = dir == 0 ? st : 15 - st;
      ebt[q] = __expf(BTb[(size_t)((bh * 2 + dir) * 16 + jj) * 128 + dd]);
    }
    __syncthreads();
#pragma unroll 1
    for (int st = 0; st < nsteps; ++st) {
      REDERIVE2
      const int jj = dir == 0 ? st : 15 - st;
      state_scan(S, SLb + (size_t)((bh * 2 + dir) * 16 + jj) * 16384, ebt + st * 128, w, r, hh);
    }
    __syncthreads();
  }
  if (dir == 0) {
#pragma unroll 1
    for (int c = 0; c < 8; ++c) hgrn_chunk<1>(p, sm, l, base + c * 32, c < 7 ? base + (c + 1) * 32 : -1, h, 0, lbv, S, pf, tid);
  } else {
#pragma unroll 1
    for (int c = 7; c >= 0; --c) hgrn_chunk<2>(p, sm, l, base + c * 32, c > 0 ? base + (c - 1) * 32 : -1, h, 1, lbv, S, pf, tid);
  }
  if (s == 0) {
    REDERIVE2
    state_store(S, p.out + OUT_ST + (size_t)(((b * 2 + l) * 2 + dir) * 4 + h) * 16384, w, r, hh);
  }
}

DI void hgrn_fin_item(const Params& p, int l, int it, int tid) {
  const int grp = it * 32 + (tid >> 3), sub = tid & 7;
  const int tok = grp >> 2, h = grp & 3;
  const size_t o = (size_t)tok * 512 + h * 128 + 16 * sub;
  const float* of = (const float*)(p.ws + OFF_OSC) + o;
  const bf16_t* ob = (const bf16_t*)(p.ws + OFF_OSB) + o;
  const bf16_t* hgp = (const bf16_t*)(p.ws + OFF_SEGH) + (size_t)tok * 2560 + 2048 + h * 128 + 16 * sub;
  const float* gn = p.in[17] + l * 128 + 16 * sub;
  float x[16];
#pragma unroll
  for (int q = 0; q < 4; ++q) { float4 v = *(const float4*)(of + 4 * q); x[4 * q] = v.x; x[4 * q + 1] = v.y; x[4 * q + 2] = v.z; x[4 * q + 3] = v.w; }
  const u32x4 b0 = *(const u32x4*)ob, b1 = *(const u32x4*)(ob + 8);
  const u32x4 h0 = *(const u32x4*)hgp, h1 = *(const u32x4*)(hgp + 8);
#pragma unroll
  for (int q = 0; q < 4; ++q) { x[2 * q] += bflo(b0[q]); x[2 * q + 1] += bfhi(b0[q]); x[8 + 2 * q] += bflo(b1[q]); x[8 + 2 * q + 1] += bfhi(b1[q]); }
  float ss = 0.f;
#pragma unroll
  for (int j = 0; j < 16; ++j) ss += x[j] * x[j];
  ss += __shfl_xor(ss, 1); ss += __shfl_xor(ss, 2); ss += __shfl_xor(ss, 4);
  const float rn = rsqrtf(ss * (1.f / 128.f) + 1e-6f);
  float y[16];
#pragma unroll
  for (int q = 0; q < 4; ++q) {
    y[2 * q] = x[2 * q] * rn * gn[2 * q] * silu(bflo(h0[q]));             y[2 * q + 1] = x[2 * q + 1] * rn * gn[2 * q + 1] * silu(bfhi(h0[q]));
    y[8 + 2 * q] = x[8 + 2 * q] * rn * gn[8 + 2 * q] * silu(bflo(h1[q])); y[8 + 2 * q + 1] = x[8 + 2 * q + 1] * rn * gn[8 + 2 * q + 1] * silu(bfhi(h1[q]));
  }
  bf16_t* ab = (bf16_t*)(p.ws + OFF_ACTB) + o;
  *(bf16x8*)ab = pack8(y[0], y[1], y[2], y[3], y[4], y[5], y[6], y[7]);
  *(bf16x8*)(ab + 8) = pack8(y[8], y[9], y[10], y[11], y[12], y[13], y[14], y[15]);
}

#define XB_TMO      128
#define XB_XCNT(j)  (256  + 64 * (j))
#define XB_XSUB(j)  (1280 + 64 * (j))
#define XB_XGEN(j)  (2304 + 64 * (j))
#define XB_TOP      3328
#define XB_TOPGEN   3392
#define XCD_BAR_WORDS 3456
#define XB_SPIN_CAP (1u << 22)
#define LAS __attribute__((address_space(3)))
DI unsigned xb_ld(unsigned* p)              { return __hip_atomic_load(p, __ATOMIC_RELAXED, __HIP_MEMORY_SCOPE_AGENT); }
DI unsigned xb_add(unsigned* p, unsigned v) { return __hip_atomic_fetch_add(p, v, __ATOMIC_RELAXED, __HIP_MEMORY_SCOPE_AGENT); }
DI unsigned xb_xcc_id() { return (unsigned)__builtin_amdgcn_s_getreg((3 << 11) | 20) & 0xFu; }
#define XB_SPIN(cond, bar) do { unsigned _sp = 0; while (cond) { __builtin_amdgcn_s_sleep(1); \
    if ((++_sp & 255u) == 0u) { if (xb_ld(&(bar)[XB_TMO])) break; if (_sp > XB_SPIN_CAP) { atomicAdd(&(bar)[XB_TMO], 1u); break; } } } } while (0)
struct XcdBarrier { unsigned* bar; unsigned x; volatile LAS unsigned* st; };
DI XcdBarrier xcd_barrier_post(unsigned* bar, volatile LAS unsigned* st) {
  XcdBarrier b; b.bar = bar; b.x = xb_xcc_id(); b.st = st;
  if (threadIdx.x == 0) (void)xb_add(&bar[XB_XCNT(b.x)], 1u);
  return b;
}
DI void xcd_barrier_complete(unsigned* bar, unsigned x, unsigned& nloc, unsigned& nx) {
  const unsigned G = gridDim.x * gridDim.y * gridDim.z;
  unsigned sum, cnt, mine, sp = 0u;
  for (;;) {
    sum = 0u; cnt = 0u; mine = 0u;
#pragma unroll
    for (unsigned j = 0; j < 16; ++j) { const unsigned c = xb_ld(&bar[XB_XCNT(j)]); sum += c; cnt += (c > 0u) ? 1u : 0u; mine = (j == x) ? c : mine; }
    if (sum == G) break;
    __builtin_amdgcn_s_sleep(1);
    if ((++sp & 255u) == 0u) { if (xb_ld(&bar[XB_TMO])) break; if (sp > XB_SPIN_CAP) { atomicAdd(&bar[XB_TMO], 1u); break; } }
  }
  nloc = mine > 0u ? mine : 1u; nx = cnt > 0u ? cnt : 1u;
}
DI void xcd_barrier(const XcdBarrier& b) {
  asm volatile("s_waitcnt vmcnt(0)" ::: "memory");
  __syncthreads();
  if (threadIdx.x == 0) {
    unsigned* bar = b.bar;
    __builtin_amdgcn_s_waitcnt(0);
    unsigned nloc = b.st[0], nx = b.st[1];
    if (nloc == 0u) { xcd_barrier_complete(bar, b.x, nloc, nx); b.st[0] = nloc; b.st[1] = nx; }
    const unsigned old = xb_add(&bar[XB_XSUB(b.x)], 1u);
    const unsigned gen = old / nloc;
    if (old + 1u == (gen + 1u) * nloc) {
      __builtin_amdgcn_fence(__ATOMIC_RELEASE, "agent");
      asm volatile("s_waitcnt vmcnt(0)" ::: "memory");
      const unsigned og = xb_add(&bar[XB_TOP], 1u);
      const unsigned tg = og / nx;
      if (og + 1u == (tg + 1u) * nx) xb_add(&bar[XB_TOPGEN], 1u);
      else XB_SPIN(xb_ld(&bar[XB_TOPGEN]) == tg, bar);
      __builtin_amdgcn_fence(__ATOMIC_ACQUIRE, "agent");
      xb_add(&bar[XB_XGEN(b.x)], 1u);
      asm volatile("s_waitcnt vmcnt(0)" ::: "memory");
    } else {
      XB_SPIN(xb_ld(&bar[XB_XGEN(b.x)]) == gen, bar);
      __builtin_amdgcn_fence(__ATOMIC_ACQUIRE, "agent");
      asm volatile("s_waitcnt vmcnt(0)" ::: "memory");
    }
  }
  __syncthreads();
}

#define OPQ unsigned zz_ = 0u; asm volatile("" : "+v"(zz_)); int tid = wv64 + (int)__builtin_amdgcn_mbcnt_hi(~0u, __builtin_amdgcn_mbcnt_lo(~0u, zz_)); asm volatile("" : "+v"(tid))

constexpr int NPH = 41;
#ifndef REP
#define REP 0
#endif

__global__ void __launch_bounds__(256, 2) fwd_kernel(Params p, int ph_lo, int ph_hi) {
  __shared__ __attribute__((aligned(16))) char smem[SMEM_BYTES];
  __shared__ uint4 xb_words;
  const int nb = gridDim.x;
  const int wv64 = __builtin_amdgcn_readfirstlane((int)(threadIdx.x & ~63u));
  XcdBarrier xb;
  if (ph_hi - ph_lo > 1) {
    if (threadIdx.x == 0) xb_words = make_uint4(0u, 0u, 0u, 0u);
    __syncthreads();
    xb = xcd_barrier_post((unsigned*)(p.ws + OFF_BAR), (volatile LAS unsigned*)&xb_words);
  }
#if REP
  for (int pp = 2 * ph_lo; pp < 2 * ph_hi; ++pp) {
    const int ph = pp >> 1;
    if ((pp & 1) && (ph == 0 || !((REP >> ((ph - 1) % 10)) & 1))) continue;
#else
  for (int ph = ph_lo; ph < ph_hi; ++ph) {
#endif
    int bid = blockIdx.x;
    asm volatile("" : "+s"(bid));
    if (ph == 0) {
      for (int it = bid; it < 192 + 64 + 1; it += nb) {
        OPQ;
        if (it < 192) mod_item(p, it, smem, tid);
        else if (it < 256) rope_item(p, it - 192, tid);
        else misc_item(p, tid);
      }
    } else {
      const int q = ph - 1;
      const int l = q / 20, s = (q / 10) & 1, k = q % 10;
      if (k == 0 && q != 0) continue;
      switch (k) {
        case 0: {
          for (int it = bid; it < 2048 + 1024; it += nb) {
        OPQ;
            if (it < 2048) norm_item(p, s, l, 0, it, tid);
            else convert_tile(p, 0, it - 2048, smem, tid);
          }
        } break;
        case 1: for (int it = bid; it < 4096; it += nb) { OPQ; gemm1_tile(p, l, it, smem, tid); } break;
        case 2: {
          const int n1 = s == 1 ? 256 : 0;
          const int nq = s == 1 ? 136 : 128;
          const int ncv = (l == 0 && s == 0) ? 1376 : 0;
          for (int it = bid; it < n1 + 512 + nq + ncv; it += nb) {
        OPQ;
            if (it < n1) hgrn_pass1_item(p, l, it, smem, tid);
            else if (it < n1 + 512) conv_item(p, s, l, it - n1, smem, tid);
            else if (it < n1 + 512 + nq) qkprep_item(p, s, l, it - n1 - 512, smem, tid);
            else convert_tile(p, 0, 1024 + it - (n1 + 512 + nq), smem, tid);
          }
        } break;
        case 3:
        {
          const int ncv = (l == 0 && s == 0) ? 2400 : 0;
#if REP
          unsigned* ctr = (unsigned*)(p.ws + OFF_BAR) + 3600 + 4 * q + (pp & 1);
#else
          unsigned* ctr = (unsigned*)(p.ws + OFF_BAR) + 3600 + 4 * q;
#endif
          for (;;) {
            __syncthreads();
            if (threadIdx.x == 0) xb_words.z = atomicAdd(ctr, 1u);
            __syncthreads();
            const int it = (int)xb_words.z;
            if (it >= 256 + 512 + ncv) break;
#if REP
            if ((pp & 1) && (REP & 0x10000) && it < 256) continue;
            if ((pp & 1) && (REP & 0x20000) && it >= 256 && it < 768) continue;
#endif
        OPQ;
            if (it < 256) hgrn_pass2_item(p, s, l, it, smem, tid);
            else if (it < 768) attn_item(p, s, l, it - 256, smem, tid);
            else convert_tile(p, 1, it - 768, smem, tid);
          }
        }
          break;
        case 4: for (int it = bid; it < 1024; it += nb) { OPQ; hgrn_fin_item(p, l, it, tid); } break;
        case 5: for (int it = bid; it < 512; it += nb) { OPQ; branch_tile(p, l, it, smem, tid); } break;
        case 6: for (int it = bid; it < 512; it += nb) { OPQ; resid_tile(p, s, l, 0, it, smem, tid); } break;
        case 7: for (int it = bid; it < 2048; it += nb) { OPQ; norm_item(p, s, l, 1, it, tid); } break;
        case 8: for (int it = bid; it < 64 * 44; it += nb) { OPQ; ffnin_tile(p, l, it, smem, tid); } break;
        case 9: {
          const int nn = (q < 30) ? 2048 : 0;
          const int s2 = s ^ 1, l2 = l + s;
          for (int it = bid; it < 512 + nn; it += nb) {
        OPQ;
            if (it < 512) resid_tile(p, s, l, 1, it, smem, tid);
            else norm_item(p, s2, l2, 0, it - 512, tid);
          }
        } break;
      }
    }
#if REP
    if (pp + 1 < 2 * ph_hi) {
#else
    if (ph + 1 < ph_hi) {
#endif
      if (ph_hi > 100000) cg::this_grid().sync();
      xcd_barrier(xb);
    }
  }
}

extern "C" void kernel_launch(void* const* d_in, const int* in_sizes, int n_in, void* d_out, int out_size, void* d_ws, size_t ws_size,
                              hipStream_t stream) {
  static int grid_blocks = 0;
  if (!grid_blocks) {
    int dev = 0, cus = 0, per_cu = 0;
    hipGetDevice(&dev);
    hipDeviceGetAttribute(&cus, hipDeviceAttributeMultiprocessorCount, dev);
    hipOccupancyMaxActiveBlocksPerMultiprocessor(&per_cu, fwd_kernel, 256, 0);
    if (per_cu < 1) per_cu = 1;
    if (per_cu > 2) per_cu = 2;
    grid_blocks = cus * per_cu;
  }
  if (ws_size < WS_END) { fprintf(stderr, "workspace too small: %zu < %zu\n", ws_size, (size_t)WS_END); return; }
  Params p{};
  for (int i = 0; i < 26; ++i) p.in[i] = (const float*)d_in[i];
  p.out = (float*)d_out;
  p.ws = (char*)d_ws;
#if MEGA
  hipMemsetAsync((char*)d_ws + OFF_BAR, 0, 16384, stream);
  int lo = 0, hi = NPH;
  void* args[] = {&p, &lo, &hi};
  hipError_t e = hipLaunchCooperativeKernel((void*)fwd_kernel, dim3(grid_blocks), dim3(256), args, 0, stream);
  if (e != hipSuccess) fprintf(stderr, "cooperative launch failed: %s (grid %d)\n", hipGetErrorString(e), grid_blocks);
#else
  for (int ph = 0; ph < NPH; ++ph) fwd_kernel<<<grid_blocks, 256, 0, stream>>>(p, ph, ph + 1);
#endif
}
```

```cpp
#include <hip/hip_runtime.h>
#include <hip/hip_cooperative_groups.h>
#include <cstdio>
namespace cg = cooperative_groups;

#ifndef MEGA
#define MEGA 1
#endif

#define DI __device__ __forceinline__
typedef unsigned short bf16_t;
typedef __attribute__((ext_vector_type(8))) short bf16x8;
typedef __attribute__((ext_vector_type(4))) short s16x4;
typedef __attribute__((ext_vector_type(16))) float f32x16;
typedef __attribute__((ext_vector_type(2))) float f32x2;
typedef __attribute__((ext_vector_type(4))) unsigned u32x4;
typedef __attribute__((ext_vector_type(2))) __bf16 bf16x2_t;
#define MFMA(a, b, c) __builtin_amdgcn_mfma_f32_32x32x16_bf16((a), (b), (c), 0, 0, 0)

DI unsigned pk2(float a, float b) { f32x2 v = {a, b}; return __builtin_bit_cast(unsigned, __builtin_convertvector(v, bf16x2_t)); }
DI bf16_t f2bf(float a) { return (bf16_t)(pk2(a, 0.f) & 0xffffu); }
DI float bf2f(bf16_t v) { return __uint_as_float(((unsigned)v) << 16); }
DI float bflo(unsigned u) { return __uint_as_float(u << 16); }
DI float bfhi(unsigned u) { return __uint_as_float(u & 0xffff0000u); }
DI float sigm(float x) { return 1.f / (1.f + __expf(-x)); }
DI float silu(float x) { return x / (1.f + __expf(-x)); }
DI bf16x8 pack8(float a0, float a1, float a2, float a3, float a4, float a5, float a6, float a7) {
  uint4 u; u.x = pk2(a0, a1); u.y = pk2(a2, a3); u.z = pk2(a4, a5); u.w = pk2(a6, a7);
  return __builtin_bit_cast(bf16x8, u);
}
#define PACK_STEP(x, s) pack8(x[8*(s)+0], x[8*(s)+1], x[8*(s)+2], x[8*(s)+3], x[8*(s)+4], x[8*(s)+5], x[8*(s)+6], x[8*(s)+7])
DI bf16x8 ld_perm(const bf16_t* p) {
  s16x4 lo = *(const s16x4*)p; s16x4 hi = *(const s16x4*)(p + 8);
  return __builtin_shufflevector(lo, hi, 0, 1, 2, 3, 4, 5, 6, 7);
}
DI int crow(int i, int hh) { return (i & 3) + 8 * (i >> 2) + 4 * hh; }
DI f32x16 zero16() { f32x16 z; for (int i = 0; i < 16; ++i) z[i] = 0.f; return z; }

constexpr int TOK = 8192;
constexpr int DFF = 2816;
constexpr size_t alignup(size_t x) { return (x + 255) & ~(size_t)255; }
constexpr size_t OFF_WIN  = 0;
constexpr size_t OFF_WBR  = OFF_WIN  + (size_t)8192 * 1024 * 2;
constexpr size_t OFF_WOUT = OFF_WBR  + (size_t)1024 * 1536 * 2;
constexpr size_t OFF_WFI  = OFF_WOUT + (size_t)1024 * 1024 * 2;
constexpr size_t OFF_WFO  = OFF_WFI  + (size_t)5632 * 1024 * 2;
constexpr size_t WSET     = OFF_WFO  + (size_t)1024 * 2816 * 2;
constexpr size_t OFF_MOD  = 2 * WSET;
constexpr size_t OFF_MISC = OFF_MOD  + (size_t)2 * 3 * 6144 * 4;
constexpr size_t OFF_ROPE = OFF_MISC + 4096;
constexpr size_t OFF_H    = OFF_ROPE + (size_t)4096 * 32 * 2 * 4;
constexpr size_t OFF_SEGA = OFF_H    + (size_t)TOK * 1024 * 2;
constexpr size_t OFF_SEGH = OFF_SEGA + (size_t)TOK * 1024 * 2;
constexpr size_t OFF_SEGC = OFF_SEGH + (size_t)TOK * 2560 * 2;
constexpr size_t OFF_SEGG = OFF_SEGC + (size_t)TOK * 1536 * 2;
constexpr size_t OFF_QN   = OFF_SEGG + (size_t)TOK * 3072 * 2;
constexpr size_t OFF_KB   = OFF_QN   + (size_t)TOK * 512 * 2;
constexpr size_t OFF_VT   = OFF_KB   + (size_t)2 * 4 * 2 * 4352 * 64 * 2;
constexpr size_t OFF_ACTA = OFF_VT   + (size_t)2 * 4 * 128 * 4352 * 2;
constexpr size_t OFF_SLOC = OFF_ACTA + (size_t)TOK * 512 * 2;
constexpr size_t OFF_BTOT = OFF_SLOC + (size_t)2 * 4 * 2 * 16 * 16384 * 4;
constexpr size_t OFF_BAR  = OFF_BTOT + (size_t)2 * 4 * 2 * 16 * 128 * 4;
constexpr size_t WS_END   = OFF_BAR + 16384;
constexpr size_t OFF_ACTB = OFF_SEGA;
constexpr size_t OFF_OC   = OFF_SEGC;
constexpr size_t OFF_OSC  = OFF_SEGC + (size_t)TOK * 512 * 2;
constexpr size_t OFF_OSB  = OFF_SEGA + (size_t)TOK * 512 * 2;
DI size_t osc_off(int s) { return s == 0 ? OFF_H : OFF_OSC; }
DI size_t osb_off(int s) { return s == 0 ? OFF_SLOC : OFF_OSB; }
constexpr size_t OFF_M    = OFF_H;
constexpr size_t OFF_FF   = OFF_SEGG;

constexpr size_t OUT_CK = (size_t)2 * TOK * 1024;
constexpr size_t OUT_CV = OUT_CK + (size_t)32 * 2 * 256 * 512;
constexpr size_t OUT_ST = OUT_CV + (size_t)32 * 2 * 256 * 512;

constexpr float QSCALE = 0.125f * 1.4426950408889634f;

struct Params { const float* in[26]; float* out; char* ws; };

constexpr int SMEM_BYTES = 73728;

constexpr int GST = 128 * 72;
template <bool DEEP>
DI void gemm_main(f32x16 (&acc)[2][2], const bf16_t* a0, size_t lda32, const bf16_t* b0, const bf16_t* b1, const bf16_t* b2, const bf16_t* b3,
                  int nk, bf16_t* sA, bf16_t* sB, int tid) {
  const int lane = tid & 63, w = tid >> 6, wm = w >> 1, wn = w & 1, r = lane & 31, hh = lane >> 5;
  const int so = (tid >> 3) * 72 + (tid & 7) * 8;
  const bf16_t* a1 = a0 + lda32; const bf16_t* a2 = a1 + lda32; const bf16_t* a3 = a2 + lda32;
  u32x4 pa0, pa1, pa2, pa3, pb0, pb1, pb2, pb3;
  u32x4 qa0, qa1, qa2, qa3, qb0, qb1, qb2, qb3;
#define GLD_P(OFF) { pa0 = *(const u32x4*)(a0 + (OFF)); pa1 = *(const u32x4*)(a1 + (OFF)); pa2 = *(const u32x4*)(a2 + (OFF)); pa3 = *(const u32x4*)(a3 + (OFF)); \
                     pb0 = *(const u32x4*)(b0 + (OFF)); pb1 = *(const u32x4*)(b1 + (OFF)); pb2 = *(const u32x4*)(b2 + (OFF)); pb3 = *(const u32x4*)(b3 + (OFF)); }
#define GLD_Q(OFF) { qa0 = *(const u32x4*)(a0 + (OFF)); qa1 = *(const u32x4*)(a1 + (OFF)); qa2 = *(const u32x4*)(a2 + (OFF)); qa3 = *(const u32x4*)(a3 + (OFF)); \
                     qb0 = *(const u32x4*)(b0 + (OFF)); qb1 = *(const u32x4*)(b1 + (OFF)); qb2 = *(const u32x4*)(b2 + (OFF)); qb3 = *(const u32x4*)(b3 + (OFF)); }
#define LST_P(ST) { bf16_t* nA_ = sA + (ST) * GST + so; bf16_t* nB_ = sB + (ST) * GST + so; \
    *(u32x4*)(nA_) = pa0; *(u32x4*)(nA_ + 32 * 72) = pa1; *(u32x4*)(nA_ + 64 * 72) = pa2; *(u32x4*)(nA_ + 96 * 72) = pa3; \
    *(u32x4*)(nB_) = pb0; *(u32x4*)(nB_ + 32 * 72) = pb1; *(u32x4*)(nB_ + 64 * 72) = pb2; *(u32x4*)(nB_ + 96 * 72) = pb3; }
#define LST_Q(ST) { bf16_t* nA_ = sA + (ST) * GST + so; bf16_t* nB_ = sB + (ST) * GST + so; \
    *(u32x4*)(nA_) = qa0; *(u32x4*)(nA_ + 32 * 72) = qa1; *(u32x4*)(nA_ + 64 * 72) = qa2; *(u32x4*)(nA_ + 96 * 72) = qa3; \
    *(u32x4*)(nB_) = qb0; *(u32x4*)(nB_ + 32 * 72) = qb1; *(u32x4*)(nB_ + 64 * 72) = qb2; *(u32x4*)(nB_ + 96 * 72) = qb3; }
#define GCOMPUTE(ST) { const bf16_t* cA = sA + (ST) * GST + (wm * 64 + r) * 72 + hh * 8; const bf16_t* cB = sB + (ST) * GST + (wn * 64 + r) * 72 + hh * 8; \
  if (DEEP) { \
    bf16x8 fa0[4], fa1[4], fb0[4], fb1[4]; \
    _Pragma("unroll") for (int ks = 0; ks < 4; ++ks) { \
      fa0[ks] = *(const bf16x8*)(cA + ks * 16); fa1[ks] = *(const bf16x8*)(cA + 32 * 72 + ks * 16); \
      fb0[ks] = *(const bf16x8*)(cB + ks * 16); fb1[ks] = *(const bf16x8*)(cB + 32 * 72 + ks * 16); } \
    __builtin_amdgcn_sched_barrier(0); \
    _Pragma("unroll") for (int ks = 0; ks < 4; ++ks) { \
      acc[0][0] = MFMA(fa0[ks], fb0[ks], acc[0][0]); acc[0][1] = MFMA(fa0[ks], fb1[ks], acc[0][1]); \
      acc[1][0] = MFMA(fa1[ks], fb0[ks], acc[1][0]); acc[1][1] = MFMA(fa1[ks], fb1[ks], acc[1][1]); } \
  } else { \
    __builtin_amdgcn_s_setprio(1); \
    _Pragma("unroll") for (int ks = 0; ks < 4; ++ks) { \
      bf16x8 fa0 = *(const bf16x8*)(cA + ks * 16), fa1 = *(const bf16x8*)(cA + 32 * 72 + ks * 16); \
      bf16x8 fb0 = *(const bf16x8*)(cB + ks * 16), fb1 = *(const bf16x8*)(cB + 32 * 72 + ks * 16); \
      acc[0][0] = MFMA(fa0, fb0, acc[0][0]); acc[0][1] = MFMA(fa0, fb1, acc[0][1]); \
      acc[1][0] = MFMA(fa1, fb0, acc[1][0]); acc[1][1] = MFMA(fa1, fb1, acc[1][1]); } \
    __builtin_amdgcn_s_setprio(0); } }
  GLD_P(0);
  __syncthreads();
  LST_P(0);
  if (!DEEP) {
    __syncthreads();
    for (int kt = 0; kt < nk; kt += 2) {
      GLD_P((size_t)(kt + 1) * 64);
      GCOMPUTE(0);
      LST_P(1);
      __syncthreads();
      const bool m2 = kt + 2 < nk;
      if (m2) GLD_P((size_t)(kt + 2) * 64);
      GCOMPUTE(1);
      if (m2) LST_P(0);
      __syncthreads();
    }
    return;
  }
  GLD_P(64);
  __syncthreads();
  for (int kt = 0; kt < nk; kt += 2) {
    const bool m2 = kt + 2 < nk;
    const size_t o2 = (size_t)(kt + 2) * 64;
    if (m2) GLD_Q(o2);
    __builtin_amdgcn_sched_barrier(0);
    GCOMPUTE(0);
    __builtin_amdgcn_sched_barrier(0);
    LST_P(1);
    __syncthreads();
    if (m2) GLD_P(o2 + 64);
    __builtin_amdgcn_sched_barrier(0);
    GCOMPUTE(1);
    __builtin_amdgcn_sched_barrier(0);
    if (m2) LST_Q(0);
    __syncthreads();
  }
#undef GLD_P
#undef GLD_Q
#undef LST_P
#undef LST_Q
#undef GCOMPUTE
}

DI void convert_tile(const Params& p, int layer, int t, char* smem, int tid) {
  const float* src; bf16_t* dst; int K, N;
  char* wb = p.ws + (size_t)layer * WSET;
  if (t < 1024)      { src = p.in[11] + (size_t)layer * 1024 * 8192; dst = (bf16_t*)(wb + OFF_WIN);  K = 1024; N = 8192; }
  else if (t < 1216) { t -= 1024; src = p.in[22] + (size_t)layer * 1536 * 1024; dst = (bf16_t*)(wb + OFF_WBR);  K = 1536; N = 1024; }
  else if (t < 1344) { t -= 1216; src = p.in[23] + (size_t)layer * 1024 * 1024; dst = (bf16_t*)(wb + OFF_WOUT); K = 1024; N = 1024; }
  else if (t < 2048) { t -= 1344; src = p.in[24] + (size_t)layer * 1024 * 5632; dst = (bf16_t*)(wb + OFF_WFI);  K = 1024; N = 5632; }
  else               { t -= 2048; src = p.in[25] + (size_t)layer * 2816 * 1024; dst = (bf16_t*)(wb + OFF_WFO);  K = 2816; N = 1024; }
  const int tn = N >> 8;
  const int n0 = (t % tn) * 256, k0 = (t / tn) * 32;
  float* T = (float*)smem;
  __syncthreads();
  {
    const float* sp = src + (size_t)(k0 + (tid >> 6)) * N + n0 + (tid & 63) * 4;
    float4 v[8];
#pragma unroll
    for (int i = 0; i < 8; ++i) v[i] = *(const float4*)(sp + (size_t)(i * 4) * N);
#pragma unroll
    for (int i = 0; i < 8; ++i) *(float4*)(T + (i * 4 + (tid >> 6)) * 260 + (tid & 63) * 4) = v[i];
  }
  __syncthreads();
  {
    float x[32];
#pragma unroll
    for (int k = 0; k < 32; ++k) x[k] = T[k * 260 + tid];
    bf16_t* dp = dst + (size_t)(n0 + tid) * K + k0;
#pragma unroll
    for (int q = 0; q < 4; ++q)
      *(bf16x8*)(dp + 8 * q) = pack8(x[8 * q], x[8 * q + 1], x[8 * q + 2], x[8 * q + 3], x[8 * q + 4], x[8 * q + 5], x[8 * q + 6], x[8 * q + 7]);
  }
}

DI void mod_item(const Params& p, int it, char* smem, int tid) {
  const int l = it / 96, chunk = it % 96;
  const int lane = tid & 63, w = tid >> 6;
  const int n = chunk * 64 + lane;
  const float* wm = p.in[7] + (size_t)l * 1024 * 6144;
  const float* c0 = p.in[6]; const float* c1 = p.in[5]; const float* c2 = p.in[5] + 1024;
  float a0 = 0.f, a1 = 0.f, a2 = 0.f;
#pragma unroll 32
  for (int k = w * 256; k < w * 256 + 256; ++k) {
    float wv = wm[(size_t)k * 6144 + n];
    a0 += silu(c0[k]) * wv; a1 += silu(c1[k]) * wv; a2 += silu(c2[k]) * wv;
  }
  float* red = (float*)smem;
  __syncthreads();
  red[(w * 3 + 0) * 64 + lane] = a0; red[(w * 3 + 1) * 64 + lane] = a1; red[(w * 3 + 2) * 64 + lane] = a2;
  __syncthreads();
  if (tid < 192) {
    int cv = tid >> 6;
    float s = red[(0 * 3 + cv) * 64 + lane] + red[(1 * 3 + cv) * 64 + lane] + red[(2 * 3 + cv) * 64 + lane] + red[(3 * 3 + cv) * 64 + lane];
    float* mod = (float*)(p.ws + OFF_MOD);
    mod[(size_t)(l * 3 + cv) * 6144 + n] = s + p.in[8][l * 6144 + n];
  }
}
DI void rope_item(const Params& p, int it, int tid) {
  float* rc = (float*)(p.ws + OFF_ROPE);
#pragma unroll
  for (int j = 0; j < 8; ++j) {
    int idx = it * 2048 + tid * 8 + j;
    int pos = idx >> 5, i = idx & 31;
    float inv = exp2f(-(float)(i & 15) * (13.287712379549449f / 16.f));
    float ang = (float)(i < 16 ? (pos >> 6) : (pos & 63)) * inv;
    rc[idx] = cosf(ang); rc[131072 + idx] = sinf(ang);
  }
}
DI void misc_item(const Params& p, int tid) {
  if (tid < 64) {
    for (int l = 0; l < 2; ++l) {
      const float* lq = p.in[20] + l * 256;
      float a = lq[tid] * lq[64 + tid], b = lq[128 + tid] * lq[192 + tid];
      for (int o = 32; o > 0; o >>= 1) { a += __shfl_xor(a, o); b += __shfl_xor(b, o); }
      if (tid == 0) {
        float lam_init = 0.8f - 0.6f * expf(-0.3f * (float)l);
        ((float*)(p.ws + OFF_MISC))[l] = expf(a) - expf(b) + lam_init;
        ((float*)(p.ws + OFF_MISC))[2 + l] = 1.f - lam_init;
      }
    }
  }
}

DI void norm_item(const Params& p, int s, int l, int which, int it, int tid) {
  const int lane = tid & 63, w = tid >> 6;
  const int row = it * 4 + w;
  const float* x;
  if (which == 0 && l == 0) x = p.in[s] + (size_t)row * 1024;
  else x = p.out + ((size_t)s * TOK + row) * 1024;
  const int cv = s == 0 ? 0 : 1 + (row >> 12);
  const float* mod = (const float*)(p.ws + OFF_MOD) + (size_t)(l * 3 + cv) * 6144 + which * 3072;
  const float* g = p.in[which == 0 ? 9 : 10] + l * 1024;
  float4 v[4]; float ss = 0.f;
#pragma unroll
  for (int i = 0; i < 4; ++i) {
    v[i] = *(const float4*)(x + 4 * (lane + 64 * i));
    ss += v[i].x * v[i].x + v[i].y * v[i].y + v[i].z * v[i].z + v[i].w * v[i].w;
  }
  for (int o = 32; o > 0; o >>= 1) ss += __shfl_xor(ss, o);
  const float rn = rsqrtf(ss * (1.f / 1024.f) + 1e-6f);
  bf16_t* h = (bf16_t*)(p.ws + OFF_H) + (size_t)row * 1024;
#pragma unroll
  for (int i = 0; i < 4; ++i) {
    const int c = 4 * (lane + 64 * i);
    float4 gg = *(const float4*)(g + c), sh = *(const float4*)(mod + c), sc = *(const float4*)(mod + 1024 + c);
    float y0 = v[i].x * rn * gg.x * (1.f + sc.x) + sh.x;
    float y1 = v[i].y * rn * gg.y * (1.f + sc.y) + sh.y;
    float y2 = v[i].z * rn * gg.z * (1.f + sc.z) + sh.z;
    float y3 = v[i].w * rn * gg.w * (1.f + sc.w) + sh.w;
    uint2 o; o.x = pk2(y0, y1); o.y = pk2(y2, y3);
    *(uint2*)(h + c) = o;
  }
}

DI void gemm1_tile(const Params& p, int l, int t, char* smem, int tid) {
  const int nb = t & 63, mb = t >> 6;
  const int m0 = mb * 128, n0 = nb * 128;
  const bf16_t* A = (const bf16_t*)(p.ws + OFF_H);
  const bf16_t* B = (const bf16_t*)(p.ws + (size_t)l * WSET + OFF_WIN);
  bf16_t* sA = (bf16_t*)smem; bf16_t* sB = sA + 2 * GST;
  f32x16 acc[2][2];
  for (int a = 0; a < 2; ++a) for (int b = 0; b < 2; ++b) acc[a][b] = zero16();
  const int lr = tid >> 3, kc = (tid & 7) * 8;
  {
    const bf16_t* bp = B + (unsigned)((n0 + lr) * 1024 + kc);
    gemm_main<false>(acc, A + (unsigned)((m0 + lr) * 1024 + kc), (size_t)32 * 1024, bp, bp + 32 * 1024, bp + 64 * 1024, bp + 96 * 1024, 16, sA, sB, tid);
  }
  bf16_t* dst; int ld, c0;
  if (n0 < 1024)      { dst = (bf16_t*)(p.ws + OFF_SEGA); ld = 1024; c0 = n0; }
  else if (n0 < 3584) { dst = (bf16_t*)(p.ws + OFF_SEGH); ld = 2560; c0 = n0 - 1024; }
  else if (n0 < 5120) { dst = (bf16_t*)(p.ws + OFF_SEGC); ld = 1536; c0 = n0 - 3584; }
  else                { dst = (bf16_t*)(p.ws + OFF_SEGG); ld = 3072; c0 = n0 - 5120; }
  const int lane = tid & 63, w = tid >> 6, wm = w >> 1, wn = w & 1, r = lane & 31, hh = lane >> 5;
  bf16_t* Gs = (bf16_t*)smem;
#pragma unroll
  for (int mi = 0; mi < 2; ++mi)
#pragma unroll
    for (int ni = 0; ni < 2; ++ni)
#pragma unroll
      for (int i = 0; i < 16; ++i)
        Gs[(wm * 64 + mi * 32 + crow(i, hh)) * 136 + wn * 64 + ni * 32 + r] = f2bf(acc[mi][ni][i]);
  __syncthreads();
  {
    const int grow = tid >> 4, gc8 = (tid & 15) * 8;
#pragma unroll
    for (int i = 0; i < 8; ++i)
      *(u32x4*)(dst + (unsigned)((m0 + grow + 16 * i) * ld + c0 + gc8)) = *(const u32x4*)(Gs + (grow + 16 * i) * 136 + gc8);
  }
}

DI void branch_tile(const Params& p, int l, int t, char* smem, int tid) {
  const int nb = t & 7, mb = t >> 3;
  const int m0 = mb * 128, n0 = nb * 128;
  bf16_t* sA = (bf16_t*)smem; bf16_t* sB = sA + 2 * GST;
  bf16_t* Gs = (bf16_t*)smem;
  const bf16_t* B = (const bf16_t*)(p.ws + (size_t)l * WSET + OFF_WBR);
  const bf16_t* G = (const bf16_t*)(p.ws + OFF_SEGG);
  const int lr = tid >> 3, kc = (tid & 7) * 8;
  const int lane = tid & 63, w = tid >> 6, wm = w >> 1, wn = w & 1, r = lane & 31, hh = lane >> 5;
  const int grow = tid >> 4, gc8 = (tid & 15) * 8;
  f32x16 tot[2][2];
  for (int a = 0; a < 2; ++a) for (int b = 0; b < 2; ++b) tot[a][b] = zero16();
#pragma unroll 1
  for (int br = 0; br < 3; ++br) {
    const bf16_t* A = (const bf16_t*)(p.ws + (br == 0 ? OFF_ACTA : (br == 1 ? OFF_ACTB : OFF_OC)));
    u32x4 gq0, gq1, gq2, gq3, gq4, gq5, gq6, gq7;
    {
      const bf16_t* gp = G + (unsigned)((m0 + grow) * 3072 + br * 1024 + n0 + gc8);
      gq0 = *(const u32x4*)(gp);             gq1 = *(const u32x4*)(gp + 16 * 3072); gq2 = *(const u32x4*)(gp + 32 * 3072); gq3 = *(const u32x4*)(gp + 48 * 3072);
      gq4 = *(const u32x4*)(gp + 64 * 3072); gq5 = *(const u32x4*)(gp + 80 * 3072); gq6 = *(const u32x4*)(gp + 96 * 3072); gq7 = *(const u32x4*)(gp + 112 * 3072);
    }
    f32x16 acc[2][2];
    for (int a = 0; a < 2; ++a) for (int b = 0; b < 2; ++b) acc[a][b] = zero16();
    {
      const bf16_t* bp = B + (unsigned)((n0 + lr) * 1536 + br * 512 + kc);
      gemm_main<false>(acc, A + (unsigned)((m0 + lr) * 512 + kc), (size_t)32 * 512, bp, bp + 32 * 1536, bp + 64 * 1536, bp + 96 * 1536, 8, sA, sB, tid);
    }
    {
      bf16_t* gs = Gs + grow * 136 + gc8;
      *(u32x4*)(gs) = gq0;            *(u32x4*)(gs + 16 * 136) = gq1; *(u32x4*)(gs + 32 * 136) = gq2; *(u32x4*)(gs + 48 * 136) = gq3;
      *(u32x4*)(gs + 64 * 136) = gq4; *(u32x4*)(gs + 80 * 136) = gq5; *(u32x4*)(gs + 96 * 136) = gq6; *(u32x4*)(gs + 112 * 136) = gq7;
    }
    __syncthreads();
#pragma unroll
    for (int mi = 0; mi < 2; ++mi)
#pragma unroll
      for (int ni = 0; ni < 2; ++ni)
#pragma unroll
        for (int i = 0; i < 16; ++i) {
          const float gte = bf2f(Gs[(wm * 64 + mi * 32 + crow(i, hh)) * 136 + wn * 64 + ni * 32 + r]);
          tot[mi][ni][i] += sigm(gte) * acc[mi][ni][i];
        }
  }
  __syncthreads();
#pragma unroll
  for (int mi = 0; mi < 2; ++mi)
#pragma unroll
    for (int ni = 0; ni < 2; ++ni)
#pragma unroll
      for (int i = 0; i < 16; ++i)
        Gs[(wm * 64 + mi * 32 + crow(i, hh)) * 136 + wn * 64 + ni * 32 + r] = f2bf(tot[mi][ni][i]);
  __syncthreads();
  bf16_t* M = (bf16_t*)(p.ws + OFF_M);
#pragma unroll
  for (int i = 0; i < 8; ++i)
    *(u32x4*)(M + (unsigned)((m0 + grow + 16 * i) * 1024 + n0 + gc8)) = *(const u32x4*)(Gs + (grow + 16 * i) * 136 + gc8);
}

DI void resid_tile(const Params& p, int s, int l, int which, int t, char* smem, int tid) {
  const int nb = t & 7, mb = t >> 3;
  const int m0 = mb * 128, n0 = nb * 128;
  bf16_t* sA = (bf16_t*)smem; bf16_t* sB = sA + 2 * GST;
  const int K = which == 0 ? 1024 : DFF;
  const bf16_t* A = (const bf16_t*)(p.ws + (which == 0 ? OFF_M : OFF_FF));
  const bf16_t* B = (const bf16_t*)(p.ws + (size_t)l * WSET + (which == 0 ? OFF_WOUT : OFF_WFO));
  const int lr = tid >> 3, kc = (tid & 7) * 8;
  f32x16 acc[2][2];
  for (int a = 0; a < 2; ++a) for (int b = 0; b < 2; ++b) acc[a][b] = zero16();
  {
    const bf16_t* bp = B + (unsigned)((n0 + lr) * K + kc);
    gemm_main<false>(acc, A + (unsigned)((m0 + lr) * K + kc), (size_t)32 * K, bp, bp + (size_t)32 * K, bp + (size_t)64 * K, bp + (size_t)96 * K, K / 64, sA, sB, tid);
  }
  const int lane = tid & 63, w = tid >> 6, wm = w >> 1, wn = w & 1, r = lane & 31, hh = lane >> 5;
  const float* xin = (which == 0 && l == 0) ? p.in[s] : p.out + (size_t)s * TOK * 1024;
  float* xout = p.out + (size_t)s * TOK * 1024;
  const int cv = s == 0 ? 0 : 1 + (m0 >> 12);
  const float* modb = (const float*)(p.ws + OFF_MOD) + (size_t)(l * 3 + cv) * 6144 + (which == 0 ? 2048 : 5120);
  float* Fs = (float*)smem;
#pragma unroll
  for (int mi = 0; mi < 2; ++mi)
#pragma unroll
    for (int ni = 0; ni < 2; ++ni)
#pragma unroll
      for (int i = 0; i < 16; ++i)
        Fs[(wm * 64 + mi * 32 + crow(i, hh)) * 132 + wn * 64 + ni * 32 + r] = acc[mi][ni][i];
  __syncthreads();
  {
    const int frow = tid >> 5, fc4 = (tid & 31) * 4;
    const float4 gt = *(const float4*)(modb + n0 + fc4);
#pragma unroll
    for (int i = 0; i < 16; ++i) {
      const unsigned idx = (unsigned)((m0 + frow + 8 * i) * 1024 + n0 + fc4);
      const float4 a4 = *(const float4*)(Fs + (frow + 8 * i) * 132 + fc4);
      const float4 x4 = *(const float4*)(xin + idx);
      float4 o4; o4.x = x4.x + gt.x * a4.x; o4.y = x4.y + gt.y * a4.y; o4.z = x4.z + gt.z * a4.z; o4.w = x4.w + gt.w * a4.w;
      *(float4*)(xout + idx) = o4;
    }
  }
}

DI void ffnin_tile(const Params& p, int l, int t, char* smem, int tid) {
  const int nb = t % 44, mb = t / 44;
  const int m0 = mb * 128, j0 = nb * 64;
  bf16_t* sA = (bf16_t*)smem; bf16_t* sB = sA + 2 * GST;
  const bf16_t* A = (const bf16_t*)(p.ws + OFF_H);
  const bf16_t* B = (const bf16_t*)(p.ws + (size_t)l * WSET + OFF_WFI);
  const int lr = tid >> 3, kc = (tid & 7) * 8;
  f32x16 acc[2][2];
  for (int a = 0; a < 2; ++a) for (int b = 0; b < 2; ++b) acc[a][b] = zero16();
  {
    const bf16_t* bp = B + (unsigned)((j0 + lr) * 1024 + kc);
    gemm_main<false>(acc, A + (unsigned)((m0 + lr) * 1024 + kc), (size_t)32 * 1024, bp, bp + (size_t)DFF * 1024, bp + (size_t)32 * 1024, bp + (size_t)(DFF + 32) * 1024,
              16, sA, sB, tid);
  }
  const int lane = tid & 63, w = tid >> 6, wm = w >> 1, wn = w & 1, r = lane & 31, hh = lane >> 5;
  bf16_t* FF = (bf16_t*)(p.ws + OFF_FF);
  bf16_t* Gs = (bf16_t*)smem;
#pragma unroll
  for (int mi = 0; mi < 2; ++mi)
#pragma unroll
    for (int i = 0; i < 16; ++i)
      Gs[(wm * 64 + mi * 32 + crow(i, hh)) * 72 + 32 * wn + r] = f2bf(silu(acc[mi][0][i]) * acc[mi][1][i]);
  __syncthreads();
  {
    const int grow = tid >> 3, gc8 = (tid & 7) * 8;
#pragma unroll
    for (int i = 0; i < 4; ++i)
      *(u32x4*)(FF + (unsigned)((m0 + grow + 32 * i) * DFF + j0 + gc8)) = *(const u32x4*)(Gs + (grow + 32 * i) * 72 + gc8);
  }
}

DI void conv_item(const Params& p, int s, int l, int it, char* smem, int tid) {
  const int ntok = s == 0 ? 256 : 4096;
  const int tile0 = it * 16;
  const int seq0 = tile0 & ~(ntok - 1);
  const int n0 = tile0 - seq0;
  const bf16_t* SA = (const bf16_t*)(p.ws + OFF_SEGA);
  const float* cw = p.in[12] + (size_t)l * 31 * 512;
  bf16_t* As = (bf16_t*)smem;
  float* Cs = (float*)smem;
  __syncthreads();
#pragma unroll 4
  for (int id = tid; id < 46 * 64; id += 256) {
    const int rr = id >> 6, c8 = (id & 63) * 8;
    const int n = n0 - 15 + rr;
    u32x4 o = {0u, 0u, 0u, 0u};
    if (n >= 0 && n < ntok) {
      const bf16_t* rp = SA + (size_t)(seq0 + n) * 1024 + c8;
      const u32x4 vv = *(const u32x4*)rp, gg = *(const u32x4*)(rp + 512);
#pragma unroll
      for (int j = 0; j < 4; ++j) o[j] = pk2(bflo(vv[j]) * sigm(bflo(gg[j])), bfhi(vv[j]) * sigm(bfhi(gg[j])));
    }
    *(u32x4*)(As + rr * 520 + c8) = o;
  }
  __syncthreads();
  float acc0[16], acc1[16];
  {
    float w0[31], w1[31];
#pragma unroll
    for (int j = 0; j < 31; ++j) { float2 t2 = *(const float2*)(cw + j * 512 + 2 * tid); w0[j] = t2.x; w1[j] = t2.y; }
    const float2 cb = *(const float2*)(p.in[13] + l * 512 + 2 * tid);
#pragma unroll
    for (int t = 0; t < 16; ++t) { acc0[t] = cb.x; acc1[t] = cb.y; }
#pragma unroll
    for (int rr = 0; rr < 46; ++rr) {
      const unsigned av = *(const unsigned*)(As + rr * 520 + 2 * tid);
      const float a0 = bflo(av), a1 = bfhi(av);
#pragma unroll
      for (int t = 0; t < 16; ++t) {
        const int j = rr - t;
        if (j >= 0 && j <= 30) { acc0[t] += a0 * w0[j]; acc1[t] += a1 * w1[j]; }
      }
    }
  }
  __syncthreads();
#pragma unroll
  for (int t = 0; t < 16; ++t) { float2 o; o.x = acc0[t]; o.y = acc1[t]; *(float2*)(Cs + t * 516 + 2 * tid) = o; }
  __syncthreads();
  const int lane = tid & 63, w = tid >> 6;
  const float* lg = p.in[14] + l * 512 + lane * 8;
  const float* lb = p.in[15] + l * 512 + lane * 8;
  bf16_t* AA = (bf16_t*)(p.ws + OFF_ACTA);
#pragma unroll
  for (int tt = 0; tt < 4; ++tt) {
    const int t = w * 4 + tt;
    float x[8];
    float4 xa = *(const float4*)(Cs + t * 516 + lane * 8), xb = *(const float4*)(Cs + t * 516 + lane * 8 + 4);
    x[0] = xa.x; x[1] = xa.y; x[2] = xa.z; x[3] = xa.w; x[4] = xb.x; x[5] = xb.y; x[6] = xb.z; x[7] = xb.w;
    float sm = 0.f;
    for (int j = 0; j < 8; ++j) sm += x[j];
    for (int o = 32; o > 0; o >>= 1) sm += __shfl_xor(sm, o);
    const float mu = sm * (1.f / 512.f);
    float vs = 0.f;
    for (int j = 0; j < 8; ++j) { x[j] -= mu; vs += x[j] * x[j]; }
    for (int o = 32; o > 0; o >>= 1) vs += __shfl_xor(vs, o);
    const float rn = rsqrtf(vs * (1.f / 512.f) + 1e-5f);
    float y[8];
    for (int j = 0; j < 8; ++j) y[j] = silu(x[j] * rn * lg[j] + lb[j]);
    *(bf16x8*)(AA + (size_t)(tile0 + t) * 512 + lane * 8) = pack8(y[0], y[1], y[2], y[3], y[4], y[5], y[6], y[7]);
  }
}

DI void qkprep_item(const Params& p, int s, int l, int it, char* smem, int tid) {
  const int lane = tid & 63, w = tid >> 6;
  const bool ctx = it >= 128;
  const int ntok = s == 0 ? 256 : 4096;
  const int M = s == 0 ? 256 : 4352;
  const int coff = s == 0 ? 0 : 256;
  int b, npos0, tok0;
  if (!ctx) { tok0 = it * 64; b = tok0 / ntok; npos0 = coff + (tok0 - b * ntok); }
  else { b = (it - 128) >> 2; tok0 = 0; npos0 = ((it - 128) & 3) * 64; }
  const bf16_t* SC = (const bf16_t*)(p.ws + OFF_SEGC);
  bf16_t* QN = (bf16_t*)(p.ws + OFF_QN);
  bf16_t* KB = (bf16_t*)(p.ws + OFF_KB);
  bf16_t* VT = (bf16_t*)(p.ws + OFF_VT);
  const float* rope = (const float*)(p.ws + OFF_ROPE);
  const int g = lane >> 3, sub = lane & 7;
#pragma unroll 4
  for (int task = w; task < 128; task += 4) {
    const int which = task >> 6, tl = task & 63;
    if (ctx && which == 0) continue;
    float x[8];
    if (!ctx) {
      uint4 raw = *(const uint4*)(SC + (size_t)(tok0 + tl) * 1536 + which * 512 + g * 64 + sub * 8);
      x[0] = bflo(raw.x); x[1] = bfhi(raw.x); x[2] = bflo(raw.y); x[3] = bfhi(raw.y);
      x[4] = bflo(raw.z); x[5] = bfhi(raw.z); x[6] = bflo(raw.w); x[7] = bfhi(raw.w);
      float ss = 0.f;
      for (int j = 0; j < 8; ++j) ss += x[j] * x[j];
      ss += __shfl_xor(ss, 1); ss += __shfl_xor(ss, 2); ss += __shfl_xor(ss, 4);
      const float rn = rsqrtf(ss * (1.f / 64.f) + 1e-6f);
      const float* nw = p.in[which == 0 ? 18 : 19] + l * 64 + sub * 8;
      for (int j = 0; j < 8; ++j) x[j] = x[j] * rn * nw[j];
      if (s == 1) {
        const int pos = (tok0 + tl) & 4095;
        float4 cc = *(const float4*)(rope + pos * 32 + sub * 4), sn = *(const float4*)(rope + 131072 + pos * 32 + sub * 4);
        float c4[4] = {cc.x, cc.y, cc.z, cc.w}, s4[4] = {sn.x, sn.y, sn.z, sn.w};
        for (int q = 0; q < 4; ++q) {
          float x1 = x[2 * q], x2 = x[2 * q + 1];
          x[2 * q] = x1 * c4[q] - x2 * s4[q]; x[2 * q + 1] = x1 * s4[q] + x2 * c4[q];
        }
      }
    } else {
      const float* ck = p.in[2] + ((size_t)(b * 2 + l) * 256 + npos0 + tl) * 512 + g * 64 + sub * 8;
      float4 xa = *(const float4*)ck, xb = *(const float4*)(ck + 4);
      x[0] = xa.x; x[1] = xa.y; x[2] = xa.z; x[3] = xa.w; x[4] = xb.x; x[5] = xb.y; x[6] = xb.z; x[7] = xb.w;
    }
    if (which == 0) {
      *(bf16x8*)(QN + (size_t)(tok0 + tl) * 512 + g * 64 + sub * 8) =
          pack8(x[0] * QSCALE, x[1] * QSCALE, x[2] * QSCALE, x[3] * QSCALE, x[4] * QSCALE, x[5] * QSCALE, x[6] * QSCALE, x[7] * QSCALE);
    } else {
      *(bf16x8*)(KB + ((size_t)(b * 8 + g) * M + npos0 + tl) * 64 + sub * 8) = pack8(x[0], x[1], x[2], x[3], x[4], x[5], x[6], x[7]);
      if (s == 0) {
        float* ok = p.out + OUT_CK + ((size_t)(b * 2 + l) * 256 + (npos0 + tl)) * 512 + g * 64 + sub * 8;
        float4 oa = {x[0], x[1], x[2], x[3]}, ob = {x[4], x[5], x[6], x[7]};
        *(float4*)ok = oa; *(float4*)(ok + 4) = ob;
      }
    }
  }
  bf16_t* Vs = (bf16_t*)smem;
  for (int hd = 0; hd < 4; ++hd) {
    __syncthreads();
#pragma unroll
    for (int i = 0; i < 4; ++i) {
      const int id = tid + 256 * i;
      const int tl = id >> 4, ch = id & 15;
      uint4 raw;
      if (!ctx) {
        raw = *(const uint4*)(SC + (size_t)(tok0 + tl) * 1536 + 1024 + hd * 128 + ch * 8);
        if (s == 0) {
          float* ov = p.out + OUT_CV + ((size_t)(b * 2 + l) * 256 + (npos0 + tl)) * 512 + hd * 128 + ch * 8;
          float4 oa = {bflo(raw.x), bfhi(raw.x), bflo(raw.y), bfhi(raw.y)}, ob = {bflo(raw.z), bfhi(raw.z), bflo(raw.w), bfhi(raw.w)};
          *(float4*)ov = oa; *(float4*)(ov + 4) = ob;
        }
      } else {
        const float* cvp = p.in[3] + ((size_t)(b * 2 + l) * 256 + npos0 + tl) * 512 + hd * 128 + ch * 8;
        float4 xa = *(const float4*)cvp, xb = *(const float4*)(cvp + 4);
        raw.x = pk2(xa.x, xa.y); raw.y = pk2(xa.z, xa.w); raw.z = pk2(xb.x, xb.y); raw.w = pk2(xb.z, xb.w);
      }
      *(uint4*)(Vs + tl * 136 + ch * 8) = raw;
    }
    __syncthreads();
    const int e = tid & 127, half = tid >> 7;
    bf16_t* dstp = VT + ((size_t)(b * 4 + hd) * 128 + e) * M + npos0 + 32 * half;
#pragma unroll
    for (int q = 0; q < 4; ++q) {
      unsigned u[4];
#pragma unroll
      for (int j = 0; j < 4; ++j) {
        unsigned lo = Vs[(32 * half + 8 * q + 2 * j) * 136 + e], hi = Vs[(32 * half + 8 * q + 2 * j + 1) * 136 + e];
        u[j] = lo | (hi << 16);
      }
      uint4 o; o.x = u[0]; o.y = u[1]; o.z = u[2]; o.w = u[3];
      *(uint4*)(dstp + 8 * q) = o;
    }
  }
}

DI void attn_item(const Params& p, int s, int l, int it, char* smem, int tid) {
  const int lane = tid & 63, w = tid >> 6, r = lane & 31, hh = lane >> 5;
  const int c = w >> 1, qsub = w & 1;
  const int ntok = s == 0 ? 256 : 4096;
  const int M = s == 0 ? 256 : 4352;
  const int qbs = ntok >> 6;
  const int qb = it % qbs, bh = it / qbs;
  const int b = bh >> 2, h = bh & 3;
  const int tq = b * ntok + qb * 64 + qsub * 32 + r;
  const bf16_t* QN = (const bf16_t*)(p.ws + OFF_QN);
  const bf16_t* Kg = (const bf16_t*)(p.ws + OFF_KB) + (size_t)bh * 2 * M * 64;
  const bf16_t* Vg = (const bf16_t*)(p.ws + OFF_VT) + (size_t)bh * 128 * M;
  bf16_t* Ks = (bf16_t*)smem;
  bf16x8 bq[4];
#pragma unroll
  for (int ks = 0; ks < 4; ++ks) bq[ks] = *(const bf16x8*)(QN + (size_t)tq * 512 + h * 128 + c * 64 + ks * 16 + hh * 8);
  f32x16 O[4];
  for (int e = 0; e < 4; ++e) O[e] = zero16();
  float mrun = -INFINITY, lrun = 0.f;
  const int nt = M >> 6;
  uint4 rk0, rk1, rk2, rk3, rv0, rv1, rv2, rv3;
  const int ch8 = (tid & 7) * 8;
  const bf16_t* kp0 = Kg + (size_t)((tid >> 3) & 63) * 64 + ch8;
  const bf16_t* kp1 = kp0 + (size_t)M * 64;
  const bf16_t* vp = Vg + (size_t)(tid >> 3) * M + ch8;
#define GLOAD(KT) { \
    rk0 = *(const uint4*)(kp0 + (size_t)(KT) * 4096); rk1 = *(const uint4*)(kp0 + (size_t)(KT) * 4096 + 2048); \
    rk2 = *(const uint4*)(kp1 + (size_t)(KT) * 4096); rk3 = *(const uint4*)(kp1 + (size_t)(KT) * 4096 + 2048); \
    rv0 = *(const uint4*)(vp + (KT) * 64); rv1 = *(const uint4*)(vp + (size_t)32 * M + (KT) * 64); \
    rv2 = *(const uint4*)(vp + (size_t)64 * M + (KT) * 64); rv3 = *(const uint4*)(vp + (size_t)96 * M + (KT) * 64); }
#define VSTORE(E, RV) { uint2 lo_, hi_; lo_.x = RV.x; lo_.y = RV.y; hi_.x = RV.z; hi_.y = RV.w; \
    *(uint2*)(Vs + (E) * 68 + ch8) = lo_; *(uint2*)(Vs + (E) * 68 + ch8 + 4) = hi_; }
  constexpr int AST = 2 * 64 * 72 + 128 * 68;
#define ASTORE(ST) { bf16_t* Kw = Ks + (ST) * AST; bf16_t* Vs = Kw + 2 * 64 * 72; const int key = (tid >> 3) & 63, e = tid >> 3; \
      *(uint4*)(Kw + (key) * 72 + ch8) = rk0; *(uint4*)(Kw + (32 + key) * 72 + ch8) = rk1; \
      *(uint4*)(Kw + (64 + key) * 72 + ch8) = rk2; *(uint4*)(Kw + (96 + key) * 72 + ch8) = rk3; \
      VSTORE(e, rv0); VSTORE(e + 32, rv1); VSTORE(e + 64, rv2); VSTORE(e + 96, rv3); }
  GLOAD(0);
  __syncthreads();
  ASTORE(0);
  if (nt > 1) GLOAD(1);
  __syncthreads();
  for (int kt = 0; kt < nt; ++kt) {
    const bf16_t* Kc = Ks + (kt & 1) * AST;
    const bf16_t* Vc = Kc + 2 * 64 * 72;
    f32x16 S[2];
    const float negm = kt == 0 ? 0.f : -mrun;
    __builtin_amdgcn_s_setprio(1);
#pragma unroll
    for (int kk = 0; kk < 2; ++kk) {
#pragma unroll
      for (int i = 0; i < 16; ++i) S[kk][i] = negm;
#pragma unroll
      for (int ks = 0; ks < 4; ++ks) {
        bf16x8 ka = *(const bf16x8*)(Kc + (c * 64 + kk * 32 + r) * 72 + ks * 16 + hh * 8);
        S[kk] = MFMA(ka, bq[ks], S[kk]);
      }
    }
    __builtin_amdgcn_s_setprio(0);
    float mx = S[0][0];
#pragma unroll
    for (int i = 0; i < 16; ++i) { mx = fmaxf(mx, S[0][i]); mx = fmaxf(mx, S[1][i]); }
    mx = fmaxf(mx, __shfl_xor(mx, 32));
    if (__builtin_amdgcn_ballot_w64(kt == 0 || mx > 8.f) != 0ull) {
      const float dm = fmaxf(mx, 0.f);
      const float mold = kt == 0 ? 0.f : mrun;
      const float mnew = kt == 0 ? mx : mold + dm;
      const float shift = mnew - mold;
      const float alpha = kt == 0 ? 0.f : __builtin_amdgcn_exp2f(-shift);
      mrun = mnew;
      lrun *= alpha;
#pragma unroll
      for (int e = 0; e < 4; ++e)
#pragma unroll
        for (int i = 0; i < 16; ++i) O[e][i] *= alpha;
#pragma unroll
      for (int i = 0; i < 16; ++i) { S[0][i] -= shift; S[1][i] -= shift; }
    }
    f32x2 ps2 = {0.f, 0.f};
#pragma unroll
    for (int i = 0; i < 16; ++i) {
      S[0][i] = __builtin_amdgcn_exp2f(S[0][i]); S[1][i] = __builtin_amdgcn_exp2f(S[1][i]);
      f32x2 t2 = {S[0][i], S[1][i]};
      ps2 += t2;
    }
    lrun += ps2[0] + ps2[1];
    bf16x8 pb[2][2];
    pb[0][0] = PACK_STEP(S[0], 0); pb[0][1] = PACK_STEP(S[0], 1); pb[1][0] = PACK_STEP(S[1], 0); pb[1][1] = PACK_STEP(S[1], 1);
    __builtin_amdgcn_s_setprio(1);
#pragma unroll
    for (int e = 0; e < 4; ++e)
#pragma unroll
      for (int kk = 0; kk < 2; ++kk)
#pragma unroll
        for (int s2 = 0; s2 < 2; ++s2) {
          bf16x8 va = ld_perm(Vc + (e * 32 + r) * 68 + kk * 32 + 16 * s2 + 4 * hh);
          O[e] = MFMA(va, pb[kk][s2], O[e]);
        }
    __builtin_amdgcn_s_setprio(0);
    __builtin_amdgcn_sched_barrier(0);
    if (kt + 1 < nt) {
      ASTORE((kt + 1) & 1);
      if (kt + 2 < nt) GLOAD(kt + 2);
    }
    __syncthreads();
  }
  const float ltot = lrun + __shfl_xor(lrun, 32);
  const float inv = 1.f / ltot;
  float* Xs = (float*)smem;
  __syncthreads();
  if (c == 1) {
#pragma unroll
    for (int e = 0; e < 4; ++e)
#pragma unroll
      for (int i = 0; i < 16; ++i) Xs[(qsub * 64 + e * 16 + i) * 64 + lane] = O[e][i] * inv;
  }
  __syncthreads();
  if (c == 0) {
    const float lam = ((const float*)(p.ws + OFF_MISC))[l];
    float ss = 0.f;
#pragma unroll
    for (int e = 0; e < 4; ++e)
#pragma unroll
      for (int i = 0; i < 16; ++i) {
        float v = O[e][i] * inv - lam * Xs[(qsub * 64 + e * 16 + i) * 64 + lane];
        O[e][i] = v; ss += v * v;
      }
    ss += __shfl_xor(ss, 32);
    const float rn = rsqrtf(ss * (1.f / 128.f) + 1e-6f) * ((const float*)(p.ws + OFF_MISC))[2 + l];
    const float* sl = p.in[21] + l * 128;
    bf16_t* OC = (bf16_t*)(p.ws + OFF_OC) + (size_t)tq * 512 + h * 128;
#pragma unroll
    for (int e = 0; e < 4; ++e)
#pragma unroll
      for (int g4 = 0; g4 < 4; ++g4) {
        const int e0 = e * 32 + 8 * g4 + 4 * hh;
        float4 sw = *(const float4*)(sl + e0);
        uint2 o;
        o.x = pk2(O[e][4 * g4 + 0] * rn * sw.x, O[e][4 * g4 + 1] * rn * sw.y);
        o.y = pk2(O[e][4 * g4 + 2] * rn * sw.z, O[e][4 * g4 + 3] * rn * sw.w);
        *(uint2*)(OC + e0) = o;
      }
  }
}

struct HgrnSmem {
  bf16_t Qs[32 * 136]; bf16_t Ks[32 * 136]; bf16_t KTs[128 * 40]; bf16_t VTs[128 * 40];
  float ebs[128]; float tot[2][128];
  bf16_t raw[3 * 4096];
};
struct HgrnPref { u32x4 z0, z1, q0, q1, v0, v1; };

template <int OUT>
DI void hgrn_prefetch(HgrnPref& pf, const bf16_t* SH, int tk0, int h, int dir, int tid) {
  const bf16_t* g = SH + (size_t)(tk0 + (tid >> 4)) * 2560 + h * 128 + (tid & 15) * 8;
  pf.z0 = *(const u32x4*)(g + 1024 + dir * 512); pf.z1 = *(const u32x4*)(g + 16 * 2560 + 1024 + dir * 512);
  pf.v0 = *(const u32x4*)(g + 512);              pf.v1 = *(const u32x4*)(g + 16 * 2560 + 512);
  if (OUT != 0) { pf.q0 = *(const u32x4*)(g);    pf.q1 = *(const u32x4*)(g + 16 * 2560); }
}

template <int OUT>
DI float hgrn_chunk(const Params& p, HgrnSmem& sm, int s, int l, int tk0, int tkn, int h, int dir, float lbv, f32x16 (&S)[4], HgrnPref& pf, int tid_in) {
  int tid = tid_in;
  asm volatile("" : "+v"(tid));
  int lane = tid & 63, w = tid >> 6, r = lane & 31, hh = lane >> 5;
  int d = tid & 127, half = tid >> 7;
#define REDERIVE { asm volatile("" : "+v"(tid)); lane = tid & 63; w = tid >> 6; r = lane & 31; hh = lane >> 5; d = tid & 127; half = tid >> 7; }
  const bf16_t* SH = (const bf16_t*)(p.ws + OFF_SEGH);
  {
    const int ro = (tid >> 4) * 128 + (tid & 15) * 8;
    *(u32x4*)(sm.raw + ro) = pf.z0; *(u32x4*)(sm.raw + ro + 16 * 128) = pf.z1;
    *(u32x4*)(sm.raw + 8192 + ro) = pf.v0; *(u32x4*)(sm.raw + 8192 + ro + 16 * 128) = pf.v1;
    if (OUT != 0) { *(u32x4*)(sm.raw + 4096 + ro) = pf.q0; *(u32x4*)(sm.raw + 4096 + ro + 16 * 128) = pf.q1; }
  }
  if (tkn >= 0) hgrn_prefetch<OUT>(pf, SH, tkn, h, dir, tid);
  __syncthreads();
  float lf[16], kg[16];
#pragma unroll
  for (int i = 0; i < 16; ++i) {
    const float z = bf2f(sm.raw[(16 * half + i) * 128 + d]);
    const float e = __expf(-z);
    const float sg = 1.f / (1.f + e);
    const float f = lbv + (1.f - lbv) * sg;
    kg[i] = (1.f - lbv) * e * sg;
    lf[i] = __logf(f);
  }
  float run = 0.f;
  if (dir == 0) {
#pragma unroll
    for (int i = 0; i < 16; ++i) { run += lf[i]; lf[i] = run; }
  } else {
#pragma unroll
    for (int i = 15; i >= 0; --i) { run += lf[i]; lf[i] = run; }
  }
  sm.tot[half][d] = run;
  __syncthreads();
  REDERIVE
  const float t0 = sm.tot[0][d], t1 = sm.tot[1][d];
  const float off = dir == 0 ? (half ? t0 : 0.f) : (half ? 0.f : t1);
  if (half == 0) sm.ebs[d] = __expf(t0 + t1);
#pragma unroll
  for (int g8 = 0; g8 < 2; ++g8) {
    float kt[8], vv[8];
#pragma unroll
    for (int i = 0; i < 8; ++i) {
      const int tl = 16 * half + 8 * g8 + i;
      vv[i] = bf2f(sm.raw[8192 + tl * 128 + d]);
      const float bb = lf[8 * g8 + i] + off;
      kt[i] = kg[8 * g8 + i] * __expf(-bb);
      sm.Ks[tl * 136 + d] = f2bf(kt[i]);
      if (OUT != 0) {
        const float qv = bf2f(sm.raw[4096 + tl * 128 + d]);
        sm.Qs[tl * 136 + d] = f2bf(silu(qv) * __expf(bb));
      }
    }
    *(bf16x8*)(sm.KTs + d * 40 + 16 * half + 8 * g8) = pack8(kt[0], kt[1], kt[2], kt[3], kt[4], kt[5], kt[6], kt[7]);
    *(bf16x8*)(sm.VTs + d * 40 + 16 * half + 8 * g8) = pack8(vv[0], vv[1], vv[2], vv[3], vv[4], vv[5], vv[6], vv[7]);
  }
  __syncthreads();
  REDERIVE
  if (OUT != 0) {
    float* OSC = (float*)(p.ws + osc_off(s));
    __builtin_amdgcn_s_setprio(1);
    f32x16 at = zero16(), at1 = zero16();
#pragma unroll
    for (int ks = 0; ks < 8; ks += 2) {
      bf16x8 ka = *(const bf16x8*)(sm.Ks + r * 136 + ks * 16 + hh * 8);
      bf16x8 qb = *(const bf16x8*)(sm.Qs + r * 136 + ks * 16 + hh * 8);
      at = MFMA(ka, qb, at);
      bf16x8 ka1 = *(const bf16x8*)(sm.Ks + r * 136 + ks * 16 + 16 + hh * 8);
      bf16x8 qb1 = *(const bf16x8*)(sm.Qs + r * 136 + ks * 16 + 16 + hh * 8);
      at1 = MFMA(ka1, qb1, at1);
    }
#pragma unroll
    for (int i = 0; i < 16; ++i) {
      const int srow = crow(i, hh);
      const bool keep = dir == 0 ? (srow <= r) : (srow >= r);
      at[i] = keep ? at[i] + at1[i] : 0.f;
    }
    __builtin_amdgcn_sched_barrier(0);
    f32x16 o = zero16();
#pragma unroll
    for (int s2 = 0; s2 < 2; ++s2) {
      bf16x8 pa = s2 == 0 ? PACK_STEP(at, 0) : PACK_STEP(at, 1);
      bf16x8 vf = ld_perm(sm.VTs + (32 * w + r) * 40 + 16 * s2 + 4 * hh);
      o = MFMA(pa, vf, o);
    }
    __builtin_amdgcn_sched_barrier(0);
    f32x16 o1 = zero16();
#pragma unroll
    for (int dt = 0; dt < 4; ++dt) {
      {
        bf16x8 qa = ld_perm(sm.Qs + r * 136 + 32 * dt + 4 * hh);
        bf16x8 sb = PACK_STEP(S[dt], 0);
        o = MFMA(qa, sb, o);
      }
      {
        bf16x8 qa = ld_perm(sm.Qs + r * 136 + 32 * dt + 16 + 4 * hh);
        bf16x8 sb = PACK_STEP(S[dt], 1);
        o1 = MFMA(qa, sb, o1);
      }
    }
#pragma unroll
    for (int i = 0; i < 16; ++i) o[i] += o1[i];
    __builtin_amdgcn_sched_barrier(0);
    if (OUT == 1) {
#pragma unroll
      for (int i = 0; i < 16; ++i) OSC[(size_t)(tk0 + crow(i, hh)) * 512 + h * 128 + 32 * w + r] = o[i];
    } else {
      bf16_t* OSB = (bf16_t*)(p.ws + osb_off(s));
#pragma unroll
      for (int i = 0; i < 16; ++i) OSB[(size_t)(tk0 + crow(i, hh)) * 512 + h * 128 + 32 * w + r] = f2bf(o[i]);
    }
  }
  __builtin_amdgcn_sched_barrier(0);
  __builtin_amdgcn_s_setprio(1);
  REDERIVE
#pragma unroll
  for (int dt = 0; dt < 4; ++dt) {
#pragma unroll
    for (int ks = 0; ks < 2; ++ks) {
      bf16x8 ka = *(const bf16x8*)(sm.KTs + (32 * dt + r) * 40 + 16 * ks + 8 * hh);
      bf16x8 vb = *(const bf16x8*)(sm.VTs + (32 * w + r) * 40 + 16 * ks + 8 * hh);
      S[dt] = MFMA(ka, vb, S[dt]);
    }
#pragma unroll
    for (int g4 = 0; g4 < 4; ++g4) {
      float4 e4 = *(const float4*)(sm.ebs + 32 * dt + 8 * g4 + 4 * hh);
      S[dt][4 * g4 + 0] *= e4.x; S[dt][4 * g4 + 1] *= e4.y; S[dt][4 * g4 + 2] *= e4.z; S[dt][4 * g4 + 3] *= e4.w;
    }
  }
  __builtin_amdgcn_s_setprio(0);
  return t0 + t1;
}

DI void state_load(f32x16 (&S)[4], const float* base, int w, int r, int hh) {
  const float* q = base + (4 * hh) * 128 + 32 * w + r;
#pragma unroll
  for (int dt = 0; dt < 4; ++dt)
#pragma unroll
    for (int g4 = 0; g4 < 4; ++g4) {
#pragma unroll
      for (int j = 0; j < 4; ++j) S[dt][4 * g4 + j] = q[j * 128];
      q += 1024;
      asm volatile("" : "+v"(q));
    }
}
DI void state_store(const f32x16 (&S)[4], float* base, int w, int r, int hh) {
  float* q = base + (4 * hh) * 128 + 32 * w + r;
#pragma unroll
  for (int dt = 0; dt < 4; ++dt)
#pragma unroll
    for (int g4 = 0; g4 < 4; ++g4) {
#pragma unroll
      for (int j = 0; j < 4; ++j) q[j * 128] = S[dt][4 * g4 + j];
      q += 1024;
      asm volatile("" : "+v"(q));
    }
}
DI void state_scan(f32x16 (&S)[4], const float* base, const float* ebs, int w, int r, int hh) {
  const float* q = base + (4 * hh) * 128 + 32 * w + r;
#pragma unroll
  for (int dt = 0; dt < 4; ++dt) {
    __builtin_amdgcn_sched_barrier(0);
#pragma unroll
    for (int g4 = 0; g4 < 4; ++g4) {
      float4 e4 = *(const float4*)(ebs + 32 * dt + 8 * g4 + 4 * hh);
      S[dt][4 * g4 + 0] = e4.x * S[dt][4 * g4 + 0] + q[0];
      S[dt][4 * g4 + 1] = e4.y * S[dt][4 * g4 + 1] + q[128];
      S[dt][4 * g4 + 2] = e4.z * S[dt][4 * g4 + 2] + q[256];
      S[dt][4 * g4 + 3] = e4.w * S[dt][4 * g4 + 3] + q[384];
      q += 1024;
      asm volatile("" : "+v"(q));
    }
  }
}

DI float hgrn_lb(const Params& p, int l, int dir, int ch) {
  if (l == 0) return 0.f;
  const float* lb = p.in[16];
  float a = lb[(0 * 2 + dir) * 512 + ch], b = lb[(1 * 2 + dir) * 512 + ch];
  return 1.f / (1.f + __expf(a - b));
}

DI void hgrn_pass1_item(const Params& p, int l, int it, char* smem, int tid) {
  HgrnSmem& sm = *(HgrnSmem*)smem;
  const int j = it & 15, dir = (it >> 4) & 1, h = (it >> 5) & 3, b = it >> 7;
  const int lane = tid & 63, w = tid >> 6, r = lane & 31, hh = lane >> 5;
  const int d = tid & 127;
  const bf16_t* SH = (const bf16_t*)(p.ws + OFF_SEGH);
  const float lbv = hgrn_lb(p, l, dir, h * 128 + d);
  f32x16 S[4];
  for (int i = 0; i < 4; ++i) S[i] = zero16();
  float bt = 0.f;
  const int base = b * 4096 + j * 256;
  HgrnPref pf = {};
  hgrn_prefetch<0>(pf, SH, base + (dir == 0 ? 0 : 7) * 32, h, dir, tid);
  __syncthreads();
#pragma unroll 1
  for (int cc = 0; cc < 8; ++cc) {
    const int c = dir == 0 ? cc : 7 - cc;
    const int cn = dir == 0 ? c + 1 : c - 1;
    bt += hgrn_chunk<0>(p, sm, 1, l, base + c * 32, cc < 7 ? base + cn * 32 : -1, h, dir, lbv, S, pf, tid);
  }
  state_store(S, (float*)(p.ws + OFF_SLOC) + (size_t)it * 16384, w, r, hh);
  if (tid < 128) ((float*)(p.ws + OFF_BTOT))[(size_t)it * 128 + d] = bt;
}

DI void hgrn_pass2_item(const Params& p, int s, int l, int it, char* smem, int tid_in) {
  HgrnSmem& sm = *(HgrnSmem*)smem;
  int tid = tid_in;
  asm volatile("" : "+v"(tid));
  const int nj = s == 0 ? 1 : 16;
  const int ntok = s == 0 ? 256 : 4096;
  const int dir = it & 1, it2 = it >> 1;
  const int j = it2 % nj, bh = it2 / nj, h = bh & 3, b = bh >> 2;
  int lane = tid & 63, w = tid >> 6, r = lane & 31, hh = lane >> 5;
  int d = tid & 127;
#define REDERIVE2 { asm volatile("" : "+v"(tid)); lane = tid & 63; w = tid >> 6; r = lane & 31; hh = lane >> 5; d = tid & 127; }
  const bf16_t* SH = (const bf16_t*)(p.ws + OFF_SEGH);
  const float* SLb = (const float*)(p.ws + OFF_SLOC);
  const float* BTb = (const float*)(p.ws + OFF_BTOT);
  const int base = b * ntok + j * 256;
  const float lbv = hgrn_lb(p, l, dir, h * 128 + d);
  HgrnPref pf = {};
  if (dir == 0) hgrn_prefetch<1>(pf, SH, base, h, 0, tid);
  else          hgrn_prefetch<2>(pf, SH, base + 7 * 32, h, 1, tid);
  f32x16 S[4];
  __syncthreads();
  if (s == 0) { for (int i = 0; i < 4; ++i) S[i] = zero16(); }
  else {
    state_load(S, p.in[4] + (size_t)(((b * 2 + l) * 2 + dir) * 4 + h) * 16384, w, r, hh);
    const int nsteps = dir == 0 ? j : 15 - j;
    float* ebt = (float*)sm.raw;
    for (int q = tid; q < nsteps * 128; q += 256) {
      const int st = q >> 7, dd = q & 127;
      const int jj = dir == 0 ? st : 15 - st;
      ebt[q] = __expf(BTb[(size_t)((bh * 2 + dir) * 16 + jj) * 128 + dd]);
    }
    __syncthreads();
#pragma unroll 1
    for (int st = 0; st < nsteps; ++st) {
      REDERIVE2
      const int jj = dir == 0 ? st : 15 - st;
      state_scan(S, SLb + (size_t)((bh * 2 + dir) * 16 + jj) * 16384, ebt + st * 128, w, r, hh);
    }
    __syncthreads();
  }
  if (dir == 0) {
#pragma unroll 1
    for (int c = 0; c < 8; ++c) hgrn_chunk<1>(p, sm, s, l, base + c * 32, c < 7 ? base + (c + 1) * 32 : -1, h, 0, lbv, S, pf, tid);
  } else {
#pragma unroll 1
    for (int c = 7; c >= 0; --c) hgrn_chunk<2>(p, sm, s, l, base + c * 32, c > 0 ? base + (c - 1) * 32 : -1, h, 1, lbv, S, pf, tid);
  }
  if (s == 0) {
    REDERIVE2
    state_store(S, p.out + OUT_ST + (size_t)(((b * 2 + l) * 2 + dir) * 4 + h) * 16384, w, r, hh);
  }
}

DI void hgrn_fin_item(const Params& p, int s, int l, int it, int tid) {
  const int grp = it * 32 + (tid >> 3), sub = tid & 7;
  const int tok = grp >> 2, h = grp & 3;
  const size_t o = (size_t)tok * 512 + h * 128 + 16 * sub;
  const float* of = (const float*)(p.ws + osc_off(s)) + o;
  const bf16_t* ob = (const bf16_t*)(p.ws + osb_off(s)) + o;
  const bf16_t* hgp = (const bf16_t*)(p.ws + OFF_SEGH) + (size_t)tok * 2560 + 2048 + h * 128 + 16 * sub;
  const float* gn = p.in[17] + l * 128 + 16 * sub;
  float x[16];
#pragma unroll
  for (int q = 0; q < 4; ++q) { float4 v = *(const float4*)(of + 4 * q); x[4 * q] = v.x; x[4 * q + 1] = v.y; x[4 * q + 2] = v.z; x[4 * q + 3] = v.w; }
  const u32x4 b0 = *(const u32x4*)ob, b1 = *(const u32x4*)(ob + 8);
  const u32x4 h0 = *(const u32x4*)hgp, h1 = *(const u32x4*)(hgp + 8);
#pragma unroll
  for (int q = 0; q < 4; ++q) { x[2 * q] += bflo(b0[q]); x[2 * q + 1] += bfhi(b0[q]); x[8 + 2 * q] += bflo(b1[q]); x[8 + 2 * q + 1] += bfhi(b1[q]); }
  float ss = 0.f;
#pragma unroll
  for (int j = 0; j < 16; ++j) ss += x[j] * x[j];
  ss += __shfl_xor(ss, 1); ss += __shfl_xor(ss, 2); ss += __shfl_xor(ss, 4);
  const float rn = rsqrtf(ss * (1.f / 128.f) + 1e-6f);
  float y[16];
#pragma unroll
  for (int q = 0; q < 4; ++q) {
    y[2 * q] = x[2 * q] * rn * gn[2 * q] * silu(bflo(h0[q]));             y[2 * q + 1] = x[2 * q + 1] * rn * gn[2 * q + 1] * silu(bfhi(h0[q]));
    y[8 + 2 * q] = x[8 + 2 * q] * rn * gn[8 + 2 * q] * silu(bflo(h1[q])); y[8 + 2 * q + 1] = x[8 + 2 * q + 1] * rn * gn[8 + 2 * q + 1] * silu(bfhi(h1[q]));
  }
  bf16_t* ab = (bf16_t*)(p.ws + OFF_ACTB) + o;
  *(bf16x8*)ab = pack8(y[0], y[1], y[2], y[3], y[4], y[5], y[6], y[7]);
  *(bf16x8*)(ab + 8) = pack8(y[8], y[9], y[10], y[11], y[12], y[13], y[14], y[15]);
}

#define XB_TMO      128
#define XB_XCNT(j)  (256  + 64 * (j))
#define XB_XSUB(j)  (1280 + 64 * (j))
#define XB_XGEN(j)  (2304 + 64 * (j))
#define XB_TOP      3328
#define XB_TOPGEN   3392
#define XCD_BAR_WORDS 3456
#define XB_SPIN_CAP (1u << 22)
#define LAS __attribute__((address_space(3)))
DI unsigned xb_ld(unsigned* p)              { return __hip_atomic_load(p, __ATOMIC_RELAXED, __HIP_MEMORY_SCOPE_AGENT); }
DI unsigned xb_add(unsigned* p, unsigned v) { return __hip_atomic_fetch_add(p, v, __ATOMIC_RELAXED, __HIP_MEMORY_SCOPE_AGENT); }
DI unsigned xb_xcc_id() { return (unsigned)__builtin_amdgcn_s_getreg((3 << 11) | 20) & 0xFu; }
#define XB_SPIN(cond, bar) do { unsigned _sp = 0; while (cond) { __builtin_amdgcn_s_sleep(1); \
    if ((++_sp & 255u) == 0u) { if (xb_ld(&(bar)[XB_TMO])) break; if (_sp > XB_SPIN_CAP) { atomicAdd(&(bar)[XB_TMO], 1u); break; } } } } while (0)
struct XcdBarrier { unsigned* bar; unsigned x; volatile LAS unsigned* st; };
DI XcdBarrier xcd_barrier_post(unsigned* bar, volatile LAS unsigned* st) {
  XcdBarrier b; b.bar = bar; b.x = xb_xcc_id(); b.st = st;
  if (threadIdx.x == 0) (void)xb_add(&bar[XB_XCNT(b.x)], 1u);
  return b;
}
DI void xcd_barrier_complete(unsigned* bar, unsigned x, unsigned& nloc, unsigned& nx) {
  const unsigned G = gridDim.x * gridDim.y * gridDim.z;
  unsigned sum, cnt, mine, sp = 0u;
  for (;;) {
    sum = 0u; cnt = 0u; mine = 0u;
#pragma unroll
    for (unsigned j = 0; j < 16; ++j) { const unsigned c = xb_ld(&bar[XB_XCNT(j)]); sum += c; cnt += (c > 0u) ? 1u : 0u; mine = (j == x) ? c : mine; }
    if (sum == G) break;
    __builtin_amdgcn_s_sleep(1);
    if ((++sp & 255u) == 0u) { if (xb_ld(&bar[XB_TMO])) break; if (sp > XB_SPIN_CAP) { atomicAdd(&bar[XB_TMO], 1u); break; } }
  }
  nloc = mine > 0u ? mine : 1u; nx = cnt > 0u ? cnt : 1u;
}
DI void xcd_barrier(const XcdBarrier& b) {
  asm volatile("s_waitcnt vmcnt(0)" ::: "memory");
  __syncthreads();
  if (threadIdx.x == 0) {
    unsigned* bar = b.bar;
    __builtin_amdgcn_s_waitcnt(0);
    unsigned nloc = b.st[0], nx = b.st[1];
    if (nloc == 0u) { xcd_barrier_complete(bar, b.x, nloc, nx); b.st[0] = nloc; b.st[1] = nx; }
    const unsigned old = xb_add(&bar[XB_XSUB(b.x)], 1u);
    const unsigned gen = old / nloc;
    if (old + 1u == (gen + 1u) * nloc) {
      __builtin_amdgcn_fence(__ATOMIC_RELEASE, "agent");
      asm volatile("s_waitcnt vmcnt(0)" ::: "memory");
      const unsigned og = xb_add(&bar[XB_TOP], 1u);
      const unsigned tg = og / nx;
      if (og + 1u == (tg + 1u) * nx) xb_add(&bar[XB_TOPGEN], 1u);
      else XB_SPIN(xb_ld(&bar[XB_TOPGEN]) == tg, bar);
      __builtin_amdgcn_fence(__ATOMIC_ACQUIRE, "agent");
      xb_add(&bar[XB_XGEN(b.x)], 1u);
      asm volatile("s_waitcnt vmcnt(0)" ::: "memory");
    } else {
      XB_SPIN(xb_ld(&bar[XB_XGEN(b.x)]) == gen, bar);
      __builtin_amdgcn_fence(__ATOMIC_ACQUIRE, "agent");
      asm volatile("s_waitcnt vmcnt(0)" ::: "memory");
    }
  }
  __syncthreads();
}

#define OPQ unsigned zz_ = 0u; asm volatile("" : "+v"(zz_)); int tid = wv64 + (int)__builtin_amdgcn_mbcnt_hi(~0u, __builtin_amdgcn_mbcnt_lo(~0u, zz_)); asm volatile("" : "+v"(tid))

constexpr int NPH = 41;
#ifndef REP
#define REP 0
#endif

__global__ void __launch_bounds__(256, 2) fwd_kernel(Params p, int ph_lo, int ph_hi) {
  __shared__ __attribute__((aligned(16))) char smem[SMEM_BYTES];
  __shared__ uint4 xb_words;
  const int nb = gridDim.x;
  const int wv64 = __builtin_amdgcn_readfirstlane((int)(threadIdx.x & ~63u));
  XcdBarrier xb;
  if (ph_hi - ph_lo > 1) {
    if (threadIdx.x == 0) xb_words = make_uint4(0u, 0u, 0u, 0u);
    __syncthreads();
    xb = xcd_barrier_post((unsigned*)(p.ws + OFF_BAR), (volatile LAS unsigned*)&xb_words);
  }
#if REP
  for (int pp = 2 * ph_lo; pp < 2 * ph_hi; ++pp) {
    const int ph = pp >> 1;
    if ((pp & 1) && (ph == 0 || !((REP >> ((ph - 1) % 10)) & 1))) continue;
#else
  for (int ph = ph_lo; ph < ph_hi; ++ph) {
#endif
    int bid = blockIdx.x;
    asm volatile("" : "+s"(bid));
    if (ph == 0) {
      for (int it = bid; it < 192 + 64 + 1; it += nb) {
        OPQ;
        if (it < 192) mod_item(p, it, smem, tid);
        else if (it < 256) rope_item(p, it - 192, tid);
        else misc_item(p, tid);
      }
    } else {
      const int q = ph - 1;
      const int l = q / 20, s = (q / 10) & 1, k = q % 10;
      if (k == 0 && q != 0) continue;
      switch (k) {
        case 0: {
          for (int it = bid; it < 2048 + 1024; it += nb) {
        OPQ;
            if (it < 2048) norm_item(p, s, l, 0, it, tid);
            else convert_tile(p, 0, it - 2048, smem, tid);
          }
        } break;
        case 1: for (int it = bid; it < 4096; it += nb) { OPQ; gemm1_tile(p, l, it, smem, tid); } break;
        case 2: {
          const int n1 = s == 1 ? 256 : 0;
          const int nq = s == 1 ? 136 : 128;
          const int ncv = (l == 0 && s == 0) ? 1376 : 0;
          if (s == 0) {
            const int ntot = 256 + 512 + nq + ncv;
            unsigned* ctr = (unsigned*)(p.ws + OFF_BAR) + 3600 + 4 * q + 2;
            for (;;) {
              __syncthreads();
              if (threadIdx.x == 0) xb_words.z = atomicAdd(ctr, 1u);
              __syncthreads();
              const int it = (int)xb_words.z;
              if (it >= ntot) break;
        OPQ;
              if (it < 256) hgrn_pass2_item(p, s, l, it, smem, tid);
              else if (it < 256 + nq) qkprep_item(p, s, l, it - 256, smem, tid);
              else if (it < 768 + nq) conv_item(p, s, l, it - 256 - nq, smem, tid);
              else convert_tile(p, 0, 1024 + it - (768 + nq), smem, tid);
            }
          } else
          for (int it = bid; it < n1 + 512 + nq + ncv; it += nb) {
        OPQ;
            if (it < n1) hgrn_pass1_item(p, l, it, smem, tid);
            else if (it < n1 + 512) conv_item(p, s, l, it - n1, smem, tid);
            else if (it < n1 + 512 + nq) qkprep_item(p, s, l, it - n1 - 512, smem, tid);
            else convert_tile(p, 0, 1024 + it - (n1 + 512 + nq), smem, tid);
          }
        } break;
        case 3:
        {
          const int ncv = (l == 0 && s == 0) ? 2400 : 0;
#if REP
          unsigned* ctr = (unsigned*)(p.ws + OFF_BAR) + 3600 + 4 * q + (pp & 1);
#else
          unsigned* ctr = (unsigned*)(p.ws + OFF_BAR) + 3600 + 4 * q;
#endif
          for (;;) {
            __syncthreads();
            if (threadIdx.x == 0) xb_words.z = atomicAdd(ctr, 1u);
            __syncthreads();
            const int it = (int)xb_words.z;
            if (it >= 256 + 512 + ncv) break;
            if (s == 0 && it < 256) continue;
#if REP
            if ((pp & 1) && (REP & 0x10000) && it < 256) continue;
            if ((pp & 1) && (REP & 0x20000) && it >= 256 && it < 768) continue;
#endif
        OPQ;
            if (it < 256) hgrn_pass2_item(p, s, l, it, smem, tid);
            else if (it < 768) attn_item(p, s, l, it - 256, smem, tid);
            else convert_tile(p, 1, it - 768, smem, tid);
          }
        }
          break;
        case 4: for (int it = bid; it < 1024; it += nb) { OPQ; hgrn_fin_item(p, s, l, it, tid); } break;
        case 5: for (int it = bid; it < 512; it += nb) { OPQ; branch_tile(p, l, it, smem, tid); } break;
        case 6: for (int it = bid; it < 512; it += nb) { OPQ; resid_tile(p, s, l, 0, it, smem, tid); } break;
        case 7: for (int it = bid; it < 2048; it += nb) { OPQ; norm_item(p, s, l, 1, it, tid); } break;
        case 8: for (int it = bid; it < 64 * 44; it += nb) { OPQ; ffnin_tile(p, l, it, smem, tid); } break;
        case 9: {
          const int nn = (q < 30) ? 2048 : 0;
          const int s2 = s ^ 1, l2 = l + s;
          for (int it = bid; it < 512 + nn; it += nb) {
        OPQ;
            if (it < 512) resid_tile(p, s, l, 1, it, smem, tid);
            else norm_item(p, s2, l2, 0, it - 512, tid);
          }
        } break;
      }
    }
#if REP
    if (pp + 1 < 2 * ph_hi) {
#else
    if (ph + 1 < ph_hi) {
#endif
      if (ph_hi > 100000) cg::this_grid().sync();
      xcd_barrier(xb);
    }
  }
}

extern "C" void kernel_launch(void* const* d_in, const int* in_sizes, int n_in, void* d_out, int out_size, void* d_ws, size_t ws_size,
                              hipStream_t stream) {
  static int grid_blocks = 0;
  if (!grid_blocks) {
    int dev = 0, cus = 0, per_cu = 0;
    hipGetDevice(&dev);
    hipDeviceGetAttribute(&cus, hipDeviceAttributeMultiprocessorCount, dev);
    hipOccupancyMaxActiveBlocksPerMultiprocessor(&per_cu, fwd_kernel, 256, 0);
    if (per_cu < 1) per_cu = 1;
    if (per_cu > 2) per_cu = 2;
    grid_blocks = cus * per_cu;
  }
  if (ws_size < WS_END) { fprintf(stderr, "workspace too small: %zu < %zu\n", ws_size, (size_t)WS_END); return; }
  Params p{};
  for (int i = 0; i < 26; ++i) p.in[i] = (const float*)d_in[i];
  p.out = (float*)d_out;
  p.ws = (char*)d_ws;
#if MEGA
  hipMemsetAsync((char*)d_ws + OFF_BAR, 0, 16384, stream);
  int lo = 0, hi = NPH;
  void* args[] = {&p, &lo, &hi};
  hipError_t e = hipLaunchCooperativeKernel((void*)fwd_kernel, dim3(grid_blocks), dim3(256), args, 0, stream);
  if (e != hipSuccess) fprintf(stderr, "cooperative launch failed: %s (grid %d)\n", hipGetErrorString(e), grid_blocks);
#else
  for (int ph = 0; ph < NPH; ++ph) fwd_kernel<<<grid_blocks, 256, 0, stream>>>(p, ph, ph + 1);
#endif
}
```

```cpp
#include <hip/hip_runtime.h>
#include <hip/hip_cooperative_groups.h>
#include <cstdio>
namespace cg = cooperative_groups;

#ifndef MEGA
#define MEGA 1
#endif

#define DI __device__ __forceinline__
typedef unsigned short bf16_t;
typedef __attribute__((ext_vector_type(8))) short bf16x8;
typedef __attribute__((ext_vector_type(4))) short s16x4;
typedef __attribute__((ext_vector_type(16))) float f32x16;
typedef __attribute__((ext_vector_type(2))) float f32x2;
typedef __attribute__((ext_vector_type(4))) unsigned u32x4;
typedef __attribute__((ext_vector_type(2))) __bf16 bf16x2_t;
#define MFMA(a, b, c) __builtin_amdgcn_mfma_f32_32x32x16_bf16((a), (b), (c), 0, 0, 0)

DI unsigned pk2(float a, float b) { f32x2 v = {a, b}; return __builtin_bit_cast(unsigned, __builtin_convertvector(v, bf16x2_t)); }
DI bf16_t f2bf(float a) { return (bf16_t)(pk2(a, 0.f) & 0xffffu); }
DI float bf2f(bf16_t v) { return __uint_as_float(((unsigned)v) << 16); }
DI float bflo(unsigned u) { return __uint_as_float(u << 16); }
DI float bfhi(unsigned u) { return __uint_as_float(u & 0xffff0000u); }
DI float sigm(float x) { return __builtin_amdgcn_rcpf(1.f + __expf(-x)); }
DI float silu(float x) { return x * __builtin_amdgcn_rcpf(1.f + __expf(-x)); }
DI bf16x8 pack8(float a0, float a1, float a2, float a3, float a4, float a5, float a6, float a7) {
  uint4 u; u.x = pk2(a0, a1); u.y = pk2(a2, a3); u.z = pk2(a4, a5); u.w = pk2(a6, a7);
  return __builtin_bit_cast(bf16x8, u);
}
#define PACK_STEP(x, s) pack8(x[8*(s)+0], x[8*(s)+1], x[8*(s)+2], x[8*(s)+3], x[8*(s)+4], x[8*(s)+5], x[8*(s)+6], x[8*(s)+7])
DI bf16x8 ld_perm(const bf16_t* p) {
  s16x4 lo = *(const s16x4*)p; s16x4 hi = *(const s16x4*)(p + 8);
  return __builtin_shufflevector(lo, hi, 0, 1, 2, 3, 4, 5, 6, 7);
}
DI int crow(int i, int hh) { return (i & 3) + 8 * (i >> 2) + 4 * hh; }
DI f32x16 zero16() { f32x16 z; for (int i = 0; i < 16; ++i) z[i] = 0.f; return z; }

constexpr int TOK = 8192;
constexpr int DFF = 2816;
constexpr size_t alignup(size_t x) { return (x + 255) & ~(size_t)255; }
constexpr size_t OFF_WIN  = 0;
constexpr size_t OFF_WBR  = OFF_WIN  + (size_t)8192 * 1024 * 2;
constexpr size_t OFF_WOUT = OFF_WBR  + (size_t)1024 * 1536 * 2;
constexpr size_t OFF_WFI  = OFF_WOUT + (size_t)1024 * 1024 * 2;
constexpr size_t OFF_WFO  = OFF_WFI  + (size_t)5632 * 1024 * 2;
constexpr size_t WSET     = OFF_WFO  + (size_t)1024 * 2816 * 2;
constexpr size_t OFF_MOD  = 2 * WSET;
constexpr size_t OFF_MISC = OFF_MOD  + (size_t)2 * 3 * 6144 * 4;
constexpr size_t OFF_ROPE = OFF_MISC + 4096;
constexpr size_t OFF_H    = OFF_ROPE + (size_t)4096 * 32 * 2 * 4;
constexpr size_t OFF_SEGA = OFF_H    + (size_t)TOK * 1024 * 2;
constexpr size_t OFF_SEGH = OFF_SEGA + (size_t)TOK * 1024 * 2;
constexpr size_t OFF_SEGC = OFF_SEGH + (size_t)TOK * 2560 * 2;
constexpr size_t OFF_SEGG = OFF_SEGC + (size_t)TOK * 1536 * 2;
constexpr size_t OFF_QN   = OFF_SEGG + (size_t)TOK * 3072 * 2;
constexpr size_t OFF_KB   = OFF_QN   + (size_t)TOK * 512 * 2;
constexpr size_t OFF_VT   = OFF_KB   + (size_t)2 * 4 * 2 * 4352 * 64 * 2;
constexpr size_t OFF_ACTA = OFF_VT   + (size_t)2 * 4 * 128 * 4352 * 2;
constexpr size_t OFF_SLOC = OFF_ACTA + (size_t)TOK * 512 * 2;
constexpr size_t OFF_BTOT = OFF_SLOC + (size_t)2 * 4 * 2 * 16 * 16384 * 4;
constexpr size_t OFF_BAR  = OFF_BTOT + (size_t)2 * 4 * 2 * 16 * 128 * 4;
constexpr size_t WS_END   = OFF_BAR + 16384;
constexpr size_t OFF_ACTB = OFF_SEGA;
constexpr size_t OFF_OC   = OFF_SEGC;
constexpr size_t OFF_OSC  = OFF_SEGC + (size_t)TOK * 512 * 2;
constexpr size_t OFF_OSB  = OFF_SEGA + (size_t)TOK * 512 * 2;
DI size_t osc_off(int s) { return s == 0 ? OFF_H : OFF_OSC; }
DI size_t osb_off(int s) { return s == 0 ? OFF_SLOC : OFF_OSB; }
constexpr size_t OFF_M    = OFF_H;
constexpr size_t OFF_FF   = OFF_SEGG;

constexpr size_t OUT_CK = (size_t)2 * TOK * 1024;
constexpr size_t OUT_CV = OUT_CK + (size_t)32 * 2 * 256 * 512;
constexpr size_t OUT_ST = OUT_CV + (size_t)32 * 2 * 256 * 512;

constexpr float QSCALE = 0.125f * 1.4426950408889634f;

struct Params { const float* in[26]; float* out; char* ws; };

constexpr int SMEM_BYTES = 73728;

constexpr int GST = 128 * 72;
template <bool DEEP>
DI void gemm_main(f32x16 (&acc)[2][2], const bf16_t* a0, size_t lda32, const bf16_t* b0, const bf16_t* b1, const bf16_t* b2, const bf16_t* b3,
                  int nk, bf16_t* sA, bf16_t* sB, int tid) {
  const int lane = tid & 63, w = tid >> 6, wm = w >> 1, wn = w & 1, r = lane & 31, hh = lane >> 5;
  const int so = (tid >> 3) * 72 + (tid & 7) * 8;
  const bf16_t* a1 = a0 + lda32; const bf16_t* a2 = a1 + lda32; const bf16_t* a3 = a2 + lda32;
  u32x4 pa0, pa1, pa2, pa3, pb0, pb1, pb2, pb3;
  u32x4 qa0, qa1, qa2, qa3, qb0, qb1, qb2, qb3;
#define GLD_P(OFF) { pa0 = *(const u32x4*)(a0 + (OFF)); pa1 = *(const u32x4*)(a1 + (OFF)); pa2 = *(const u32x4*)(a2 + (OFF)); pa3 = *(const u32x4*)(a3 + (OFF)); \
                     pb0 = *(const u32x4*)(b0 + (OFF)); pb1 = *(const u32x4*)(b1 + (OFF)); pb2 = *(const u32x4*)(b2 + (OFF)); pb3 = *(const u32x4*)(b3 + (OFF)); }
#define GLD_Q(OFF) { qa0 = *(const u32x4*)(a0 + (OFF)); qa1 = *(const u32x4*)(a1 + (OFF)); qa2 = *(const u32x4*)(a2 + (OFF)); qa3 = *(const u32x4*)(a3 + (OFF)); \
                     qb0 = *(const u32x4*)(b0 + (OFF)); qb1 = *(const u32x4*)(b1 + (OFF)); qb2 = *(const u32x4*)(b2 + (OFF)); qb3 = *(const u32x4*)(b3 + (OFF)); }
#define LST_P(ST) { bf16_t* nA_ = sA + (ST) * GST + so; bf16_t* nB_ = sB + (ST) * GST + so; \
    *(u32x4*)(nA_) = pa0; *(u32x4*)(nA_ + 32 * 72) = pa1; *(u32x4*)(nA_ + 64 * 72) = pa2; *(u32x4*)(nA_ + 96 * 72) = pa3; \
    *(u32x4*)(nB_) = pb0; *(u32x4*)(nB_ + 32 * 72) = pb1; *(u32x4*)(nB_ + 64 * 72) = pb2; *(u32x4*)(nB_ + 96 * 72) = pb3; }
#define LST_Q(ST) { bf16_t* nA_ = sA + (ST) * GST + so; bf16_t* nB_ = sB + (ST) * GST + so; \
    *(u32x4*)(nA_) = qa0; *(u32x4*)(nA_ + 32 * 72) = qa1; *(u32x4*)(nA_ + 64 * 72) = qa2; *(u32x4*)(nA_ + 96 * 72) = qa3; \
    *(u32x4*)(nB_) = qb0; *(u32x4*)(nB_ + 32 * 72) = qb1; *(u32x4*)(nB_ + 64 * 72) = qb2; *(u32x4*)(nB_ + 96 * 72) = qb3; }
#define GCOMPUTE(ST) { const bf16_t* cA = sA + (ST) * GST + (wm * 64 + r) * 72 + hh * 8; const bf16_t* cB = sB + (ST) * GST + (wn * 64 + r) * 72 + hh * 8; \
  if (DEEP) { \
    bf16x8 fa0[4], fa1[4], fb0[4], fb1[4]; \
    _Pragma("unroll") for (int ks = 0; ks < 4; ++ks) { \
      fa0[ks] = *(const bf16x8*)(cA + ks * 16); fa1[ks] = *(const bf16x8*)(cA + 32 * 72 + ks * 16); \
      fb0[ks] = *(const bf16x8*)(cB + ks * 16); fb1[ks] = *(const bf16x8*)(cB + 32 * 72 + ks * 16); } \
    __builtin_amdgcn_sched_barrier(0); \
    _Pragma("unroll") for (int ks = 0; ks < 4; ++ks) { \
      acc[0][0] = MFMA(fa0[ks], fb0[ks], acc[0][0]); acc[0][1] = MFMA(fa0[ks], fb1[ks], acc[0][1]); \
      acc[1][0] = MFMA(fa1[ks], fb0[ks], acc[1][0]); acc[1][1] = MFMA(fa1[ks], fb1[ks], acc[1][1]); } \
  } else { \
    __builtin_amdgcn_s_setprio(1); \
    _Pragma("unroll") for (int ks = 0; ks < 4; ++ks) { \
      bf16x8 fa0 = *(const bf16x8*)(cA + ks * 16), fa1 = *(const bf16x8*)(cA + 32 * 72 + ks * 16); \
      bf16x8 fb0 = *(const bf16x8*)(cB + ks * 16), fb1 = *(const bf16x8*)(cB + 32 * 72 + ks * 16); \
      acc[0][0] = MFMA(fa0, fb0, acc[0][0]); acc[0][1] = MFMA(fa0, fb1, acc[0][1]); \
      acc[1][0] = MFMA(fa1, fb0, acc[1][0]); acc[1][1] = MFMA(fa1, fb1, acc[1][1]); } \
    __builtin_amdgcn_s_setprio(0); } }
  GLD_P(0);
  __syncthreads();
  LST_P(0);
  if (!DEEP) {
    __syncthreads();
    for (int kt = 0; kt < nk; kt += 2) {
      GLD_P((size_t)(kt + 1) * 64);
      GCOMPUTE(0);
      LST_P(1);
      __syncthreads();
      const bool m2 = kt + 2 < nk;
      if (m2) GLD_P((size_t)(kt + 2) * 64);
      GCOMPUTE(1);
      if (m2) LST_P(0);
      __syncthreads();
    }
    return;
  }
  GLD_P(64);
  __syncthreads();
  for (int kt = 0; kt < nk; kt += 2) {
    const bool m2 = kt + 2 < nk;
    const size_t o2 = (size_t)(kt + 2) * 64;
    if (m2) GLD_Q(o2);
    __builtin_amdgcn_sched_barrier(0);
    GCOMPUTE(0);
    __builtin_amdgcn_sched_barrier(0);
    LST_P(1);
    __syncthreads();
    if (m2) GLD_P(o2 + 64);
    __builtin_amdgcn_sched_barrier(0);
    GCOMPUTE(1);
    __builtin_amdgcn_sched_barrier(0);
    if (m2) LST_Q(0);
    __syncthreads();
  }
#undef GLD_P
#undef GLD_Q
#undef LST_P
#undef LST_Q
#undef GCOMPUTE
}

DI void convert_tile(const Params& p, int layer, int t, char* smem, int tid) {
  const float* src; bf16_t* dst; int K, N;
  char* wb = p.ws + (size_t)layer * WSET;
  if (t < 1024)      { src = p.in[11] + (size_t)layer * 1024 * 8192; dst = (bf16_t*)(wb + OFF_WIN);  K = 1024; N = 8192; }
  else if (t < 1216) { t -= 1024; src = p.in[22] + (size_t)layer * 1536 * 1024; dst = (bf16_t*)(wb + OFF_WBR);  K = 1536; N = 1024; }
  else if (t < 1344) { t -= 1216; src = p.in[23] + (size_t)layer * 1024 * 1024; dst = (bf16_t*)(wb + OFF_WOUT); K = 1024; N = 1024; }
  else if (t < 2048) { t -= 1344; src = p.in[24] + (size_t)layer * 1024 * 5632; dst = (bf16_t*)(wb + OFF_WFI);  K = 1024; N = 5632; }
  else               { t -= 2048; src = p.in[25] + (size_t)layer * 2816 * 1024; dst = (bf16_t*)(wb + OFF_WFO);  K = 2816; N = 1024; }
  const int tn = N >> 8;
  const int n0 = (t % tn) * 256, k0 = (t / tn) * 32;
  float* T = (float*)smem;
  __syncthreads();
  {
    const float* sp = src + (size_t)(k0 + (tid >> 6)) * N + n0 + (tid & 63) * 4;
    float4 v[8];
#pragma unroll
    for (int i = 0; i < 8; ++i) v[i] = *(const float4*)(sp + (size_t)(i * 4) * N);
#pragma unroll
    for (int i = 0; i < 8; ++i) *(float4*)(T + (i * 4 + (tid >> 6)) * 260 + (tid & 63) * 4) = v[i];
  }
  __syncthreads();
  {
    float x[32];
#pragma unroll
    for (int k = 0; k < 32; ++k) x[k] = T[k * 260 + tid];
    bf16_t* dp = dst + (size_t)(n0 + tid) * K + k0;
#pragma unroll
    for (int q = 0; q < 4; ++q)
      *(bf16x8*)(dp + 8 * q) = pack8(x[8 * q], x[8 * q + 1], x[8 * q + 2], x[8 * q + 3], x[8 * q + 4], x[8 * q + 5], x[8 * q + 6], x[8 * q + 7]);
  }
}

DI void mod_item(const Params& p, int it, char* smem, int tid) {
  const int l = it / 96, chunk = it % 96;
  const int lane = tid & 63, w = tid >> 6;
  const int n = chunk * 64 + lane;
  const float* wm = p.in[7] + (size_t)l * 1024 * 6144;
  const float* c0 = p.in[6]; const float* c1 = p.in[5]; const float* c2 = p.in[5] + 1024;
  float a0 = 0.f, a1 = 0.f, a2 = 0.f;
#pragma unroll 32
  for (int k = w * 256; k < w * 256 + 256; ++k) {
    float wv = wm[(size_t)k * 6144 + n];
    a0 += silu(c0[k]) * wv; a1 += silu(c1[k]) * wv; a2 += silu(c2[k]) * wv;
  }
  float* red = (float*)smem;
  __syncthreads();
  red[(w * 3 + 0) * 64 + lane] = a0; red[(w * 3 + 1) * 64 + lane] = a1; red[(w * 3 + 2) * 64 + lane] = a2;
  __syncthreads();
  if (tid < 192) {
    int cv = tid >> 6;
    float s = red[(0 * 3 + cv) * 64 + lane] + red[(1 * 3 + cv) * 64 + lane] + red[(2 * 3 + cv) * 64 + lane] + red[(3 * 3 + cv) * 64 + lane];
    float* mod = (float*)(p.ws + OFF_MOD);
    mod[(size_t)(l * 3 + cv) * 6144 + n] = s + p.in[8][l * 6144 + n];
  }
}
DI void rope_item(const Params& p, int it, int tid) {
  float* rc = (float*)(p.ws + OFF_ROPE);
#pragma unroll
  for (int j = 0; j < 8; ++j) {
    int idx = it * 2048 + tid * 8 + j;
    int pos = idx >> 5, i = idx & 31;
    float inv = exp2f(-(float)(i & 15) * (13.287712379549449f / 16.f));
    float ang = (float)(i < 16 ? (pos >> 6) : (pos & 63)) * inv;
    rc[idx] = cosf(ang); rc[131072 + idx] = sinf(ang);
  }
}
DI void misc_item(const Params& p, int tid) {
  if (tid < 64) {
    for (int l = 0; l < 2; ++l) {
      const float* lq = p.in[20] + l * 256;
      float a = lq[tid] * lq[64 + tid], b = lq[128 + tid] * lq[192 + tid];
      for (int o = 32; o > 0; o >>= 1) { a += __shfl_xor(a, o); b += __shfl_xor(b, o); }
      if (tid == 0) {
        float lam_init = 0.8f - 0.6f * expf(-0.3f * (float)l);
        ((float*)(p.ws + OFF_MISC))[l] = expf(a) - expf(b) + lam_init;
        ((float*)(p.ws + OFF_MISC))[2 + l] = 1.f - lam_init;
      }
    }
  }
}

DI void norm_item(const Params& p, int s, int l, int which, int it, int tid) {
  const int lane = tid & 63, w = tid >> 6;
  const int row = it * 4 + w;
  const float* x;
  if (which == 0 && l == 0) x = p.in[s] + (size_t)row * 1024;
  else x = p.out + ((size_t)s * TOK + row) * 1024;
  const int cv = s == 0 ? 0 : 1 + (row >> 12);
  const float* mod = (const float*)(p.ws + OFF_MOD) + (size_t)(l * 3 + cv) * 6144 + which * 3072;
  const float* g = p.in[which == 0 ? 9 : 10] + l * 1024;
  float4 v[4]; float ss = 0.f;
#pragma unroll
  for (int i = 0; i < 4; ++i) {
    v[i] = *(const float4*)(x + 4 * (lane + 64 * i));
    ss += v[i].x * v[i].x + v[i].y * v[i].y + v[i].z * v[i].z + v[i].w * v[i].w;
  }
  for (int o = 32; o > 0; o >>= 1) ss += __shfl_xor(ss, o);
  const float rn = rsqrtf(ss * (1.f / 1024.f) + 1e-6f);
  bf16_t* h = (bf16_t*)(p.ws + OFF_H) + (size_t)row * 1024;
#pragma unroll
  for (int i = 0; i < 4; ++i) {
    const int c = 4 * (lane + 64 * i);
    float4 gg = *(const float4*)(g + c), sh = *(const float4*)(mod + c), sc = *(const float4*)(mod + 1024 + c);
    float y0 = v[i].x * rn * gg.x * (1.f + sc.x) + sh.x;
    float y1 = v[i].y * rn * gg.y * (1.f + sc.y) + sh.y;
    float y2 = v[i].z * rn * gg.z * (1.f + sc.z) + sh.z;
    float y3 = v[i].w * rn * gg.w * (1.f + sc.w) + sh.w;
    uint2 o; o.x = pk2(y0, y1); o.y = pk2(y2, y3);
    *(uint2*)(h + c) = o;
  }
}

DI void gemm1_tile(const Params& p, int l, int t, char* smem, int tid) {
  const int nb = t & 63, mb = t >> 6;
  const int m0 = mb * 128, n0 = nb * 128;
  const bf16_t* A = (const bf16_t*)(p.ws + OFF_H);
  const bf16_t* B = (const bf16_t*)(p.ws + (size_t)l * WSET + OFF_WIN);
  bf16_t* sA = (bf16_t*)smem; bf16_t* sB = sA + 2 * GST;
  f32x16 acc[2][2];
  for (int a = 0; a < 2; ++a) for (int b = 0; b < 2; ++b) acc[a][b] = zero16();
  const int lr = tid >> 3, kc = (tid & 7) * 8;
  {
    const bf16_t* bp = B + (unsigned)((n0 + lr) * 1024 + kc);
    gemm_main<false>(acc, A + (unsigned)((m0 + lr) * 1024 + kc), (size_t)32 * 1024, bp, bp + 32 * 1024, bp + 64 * 1024, bp + 96 * 1024, 16, sA, sB, tid);
  }
  bf16_t* dst; int ld, c0;
  if (n0 < 1024)      { dst = (bf16_t*)(p.ws + OFF_SEGA); ld = 1024; c0 = n0; }
  else if (n0 < 3584) { dst = (bf16_t*)(p.ws + OFF_SEGH); ld = 2560; c0 = n0 - 1024; }
  else if (n0 < 5120) { dst = (bf16_t*)(p.ws + OFF_SEGC); ld = 1536; c0 = n0 - 3584; }
  else                { dst = (bf16_t*)(p.ws + OFF_SEGG); ld = 3072; c0 = n0 - 5120; }
  const int lane = tid & 63, w = tid >> 6, wm = w >> 1, wn = w & 1, r = lane & 31, hh = lane >> 5;
  bf16_t* Gs = (bf16_t*)smem;
#pragma unroll
  for (int mi = 0; mi < 2; ++mi)
#pragma unroll
    for (int ni = 0; ni < 2; ++ni)
#pragma unroll
      for (int i = 0; i < 16; ++i)
        Gs[(wm * 64 + mi * 32 + crow(i, hh)) * 136 + wn * 64 + ni * 32 + r] = f2bf(acc[mi][ni][i]);
  __syncthreads();
  {
    const int grow = tid >> 4, gc8 = (tid & 15) * 8;
#pragma unroll
    for (int i = 0; i < 8; ++i)
      *(u32x4*)(dst + (unsigned)((m0 + grow + 16 * i) * ld + c0 + gc8)) = *(const u32x4*)(Gs + (grow + 16 * i) * 136 + gc8);
  }
}

DI void branch_tile(const Params& p, int l, int t, char* smem, int tid) {
  const int nb = t & 7, mb = t >> 3;
  const int m0 = mb * 128, n0 = nb * 128;
  bf16_t* sA = (bf16_t*)smem; bf16_t* sB = sA + 2 * GST;
  bf16_t* Gs = (bf16_t*)smem;
  const bf16_t* B = (const bf16_t*)(p.ws + (size_t)l * WSET + OFF_WBR);
  const bf16_t* G = (const bf16_t*)(p.ws + OFF_SEGG);
  const int lr = tid >> 3, kc = (tid & 7) * 8;
  const int lane = tid & 63, w = tid >> 6, wm = w >> 1, wn = w & 1, r = lane & 31, hh = lane >> 5;
  const int grow = tid >> 4, gc8 = (tid & 15) * 8;
  f32x16 tot[2][2];
  for (int a = 0; a < 2; ++a) for (int b = 0; b < 2; ++b) tot[a][b] = zero16();
#pragma unroll 1
  for (int br = 0; br < 3; ++br) {
    const bf16_t* A = (const bf16_t*)(p.ws + (br == 0 ? OFF_ACTA : (br == 1 ? OFF_ACTB : OFF_OC)));
    u32x4 gq0, gq1, gq2, gq3, gq4, gq5, gq6, gq7;
    {
      const bf16_t* gp = G + (unsigned)((m0 + grow) * 3072 + br * 1024 + n0 + gc8);
      gq0 = *(const u32x4*)(gp);             gq1 = *(const u32x4*)(gp + 16 * 3072); gq2 = *(const u32x4*)(gp + 32 * 3072); gq3 = *(const u32x4*)(gp + 48 * 3072);
      gq4 = *(const u32x4*)(gp + 64 * 3072); gq5 = *(const u32x4*)(gp + 80 * 3072); gq6 = *(const u32x4*)(gp + 96 * 3072); gq7 = *(const u32x4*)(gp + 112 * 3072);
    }
    f32x16 acc[2][2];
    for (int a = 0; a < 2; ++a) for (int b = 0; b < 2; ++b) acc[a][b] = zero16();
    {
      const bf16_t* bp = B + (unsigned)((n0 + lr) * 1536 + br * 512 + kc);
      gemm_main<false>(acc, A + (unsigned)((m0 + lr) * 512 + kc), (size_t)32 * 512, bp, bp + 32 * 1536, bp + 64 * 1536, bp + 96 * 1536, 8, sA, sB, tid);
    }
    {
      bf16_t* gs = Gs + grow * 136 + gc8;
      *(u32x4*)(gs) = gq0;            *(u32x4*)(gs + 16 * 136) = gq1; *(u32x4*)(gs + 32 * 136) = gq2; *(u32x4*)(gs + 48 * 136) = gq3;
      *(u32x4*)(gs + 64 * 136) = gq4; *(u32x4*)(gs + 80 * 136) = gq5; *(u32x4*)(gs + 96 * 136) = gq6; *(u32x4*)(gs + 112 * 136) = gq7;
    }
    __syncthreads();
#pragma unroll
    for (int mi = 0; mi < 2; ++mi)
#pragma unroll
      for (int ni = 0; ni < 2; ++ni)
#pragma unroll
        for (int i = 0; i < 16; ++i) {
          const float gte = bf2f(Gs[(wm * 64 + mi * 32 + crow(i, hh)) * 136 + wn * 64 + ni * 32 + r]);
          tot[mi][ni][i] += sigm(gte) * acc[mi][ni][i];
        }
  }
  __syncthreads();
#pragma unroll
  for (int mi = 0; mi < 2; ++mi)
#pragma unroll
    for (int ni = 0; ni < 2; ++ni)
#pragma unroll
      for (int i = 0; i < 16; ++i)
        Gs[(wm * 64 + mi * 32 + crow(i, hh)) * 136 + wn * 64 + ni * 32 + r] = f2bf(tot[mi][ni][i]);
  __syncthreads();
  bf16_t* M = (bf16_t*)(p.ws + OFF_M);
#pragma unroll
  for (int i = 0; i < 8; ++i)
    *(u32x4*)(M + (unsigned)((m0 + grow + 16 * i) * 1024 + n0 + gc8)) = *(const u32x4*)(Gs + (grow + 16 * i) * 136 + gc8);
}

DI void resid_tile(const Params& p, int s, int l, int which, int t, char* smem, int tid) {
  const int nb = t & 7, mb = t >> 3;
  const int m0 = mb * 128, n0 = nb * 128;
  bf16_t* sA = (bf16_t*)smem; bf16_t* sB = sA + 2 * GST;
  const int K = which == 0 ? 1024 : DFF;
  const bf16_t* A = (const bf16_t*)(p.ws + (which == 0 ? OFF_M : OFF_FF));
  const bf16_t* B = (const bf16_t*)(p.ws + (size_t)l * WSET + (which == 0 ? OFF_WOUT : OFF_WFO));
  const int lr = tid >> 3, kc = (tid & 7) * 8;
  f32x16 acc[2][2];
  for (int a = 0; a < 2; ++a) for (int b = 0; b < 2; ++b) acc[a][b] = zero16();
  {
    const bf16_t* bp = B + (unsigned)((n0 + lr) * K + kc);
    gemm_main<false>(acc, A + (unsigned)((m0 + lr) * K + kc), (size_t)32 * K, bp, bp + (size_t)32 * K, bp + (size_t)64 * K, bp + (size_t)96 * K, K / 64, sA, sB, tid);
  }
  const int lane = tid & 63, w = tid >> 6, wm = w >> 1, wn = w & 1, r = lane & 31, hh = lane >> 5;
  const float* xin = (which == 0 && l == 0) ? p.in[s] : p.out + (size_t)s * TOK * 1024;
  float* xout = p.out + (size_t)s * TOK * 1024;
  const int cv = s == 0 ? 0 : 1 + (m0 >> 12);
  const float* modb = (const float*)(p.ws + OFF_MOD) + (size_t)(l * 3 + cv) * 6144 + (which == 0 ? 2048 : 5120);
  float* Fs = (float*)smem;
#pragma unroll
  for (int mi = 0; mi < 2; ++mi)
#pragma unroll
    for (int ni = 0; ni < 2; ++ni)
#pragma unroll
      for (int i = 0; i < 16; ++i)
        Fs[(wm * 64 + mi * 32 + crow(i, hh)) * 132 + wn * 64 + ni * 32 + r] = acc[mi][ni][i];
  __syncthreads();
  {
    const int frow = tid >> 5, fc4 = (tid & 31) * 4;
    const float4 gt = *(const float4*)(modb + n0 + fc4);
#pragma unroll
    for (int i = 0; i < 16; ++i) {
      const unsigned idx = (unsigned)((m0 + frow + 8 * i) * 1024 + n0 + fc4);
      const float4 a4 = *(const float4*)(Fs + (frow + 8 * i) * 132 + fc4);
      const float4 x4 = *(const float4*)(xin + idx);
      float4 o4; o4.x = x4.x + gt.x * a4.x; o4.y = x4.y + gt.y * a4.y; o4.z = x4.z + gt.z * a4.z; o4.w = x4.w + gt.w * a4.w;
      *(float4*)(xout + idx) = o4;
    }
  }
}

DI void ffnin_tile(const Params& p, int l, int t, char* smem, int tid) {
  const int nb = t % 44, mb = t / 44;
  const int m0 = mb * 128, j0 = nb * 64;
  bf16_t* sA = (bf16_t*)smem; bf16_t* sB = sA + 2 * GST;
  const bf16_t* A = (const bf16_t*)(p.ws + OFF_H);
  const bf16_t* B = (const bf16_t*)(p.ws + (size_t)l * WSET + OFF_WFI);
  const int lr = tid >> 3, kc = (tid & 7) * 8;
  f32x16 acc[2][2];
  for (int a = 0; a < 2; ++a) for (int b = 0; b < 2; ++b) acc[a][b] = zero16();
  {
    const bf16_t* bp = B + (unsigned)((j0 + lr) * 1024 + kc);
    gemm_main<false>(acc, A + (unsigned)((m0 + lr) * 1024 + kc), (size_t)32 * 1024, bp, bp + (size_t)DFF * 1024, bp + (size_t)32 * 1024, bp + (size_t)(DFF + 32) * 1024,
              16, sA, sB, tid);
  }
  const int lane = tid & 63, w = tid >> 6, wm = w >> 1, wn = w & 1, r = lane & 31, hh = lane >> 5;
  bf16_t* FF = (bf16_t*)(p.ws + OFF_FF);
  bf16_t* Gs = (bf16_t*)smem;
#pragma unroll
  for (int mi = 0; mi < 2; ++mi)
#pragma unroll
    for (int i = 0; i < 16; ++i)
      Gs[(wm * 64 + mi * 32 + crow(i, hh)) * 72 + 32 * wn + r] = f2bf(silu(acc[mi][0][i]) * acc[mi][1][i]);
  __syncthreads();
  {
    const int grow = tid >> 3, gc8 = (tid & 7) * 8;
#pragma unroll
    for (int i = 0; i < 4; ++i)
      *(u32x4*)(FF + (unsigned)((m0 + grow + 32 * i) * DFF + j0 + gc8)) = *(const u32x4*)(Gs + (grow + 32 * i) * 72 + gc8);
  }
}

DI void conv_item(const Params& p, int s, int l, int it, char* smem, int tid) {
  const int ntok = s == 0 ? 256 : 4096;
  const int tile0 = it * 16;
  const int seq0 = tile0 & ~(ntok - 1);
  const int n0 = tile0 - seq0;
  const bf16_t* SA = (const bf16_t*)(p.ws + OFF_SEGA);
  const float* cw = p.in[12] + (size_t)l * 31 * 512;
  bf16_t* As = (bf16_t*)smem;
  float* Cs = (float*)smem;
  __syncthreads();
#pragma unroll 4
  for (int id = tid; id < 46 * 64; id += 256) {
    const int rr = id >> 6, c8 = (id & 63) * 8;
    const int n = n0 - 15 + rr;
    u32x4 o = {0u, 0u, 0u, 0u};
    if (n >= 0 && n < ntok) {
      const bf16_t* rp = SA + (size_t)(seq0 + n) * 1024 + c8;
      const u32x4 vv = *(const u32x4*)rp, gg = *(const u32x4*)(rp + 512);
#pragma unroll
      for (int j = 0; j < 4; ++j) o[j] = pk2(bflo(vv[j]) * sigm(bflo(gg[j])), bfhi(vv[j]) * sigm(bfhi(gg[j])));
    }
    *(u32x4*)(As + rr * 520 + c8) = o;
  }
  __syncthreads();
  float acc0[16], acc1[16];
  {
    float w0[31], w1[31];
#pragma unroll
    for (int j = 0; j < 31; ++j) { float2 t2 = *(const float2*)(cw + j * 512 + 2 * tid); w0[j] = t2.x; w1[j] = t2.y; }
    const float2 cb = *(const float2*)(p.in[13] + l * 512 + 2 * tid);
#pragma unroll
    for (int t = 0; t < 16; ++t) { acc0[t] = cb.x; acc1[t] = cb.y; }
#pragma unroll
    for (int rr = 0; rr < 46; ++rr) {
      const unsigned av = *(const unsigned*)(As + rr * 520 + 2 * tid);
      const float a0 = bflo(av), a1 = bfhi(av);
#pragma unroll
      for (int t = 0; t < 16; ++t) {
        const int j = rr - t;
        if (j >= 0 && j <= 30) { acc0[t] += a0 * w0[j]; acc1[t] += a1 * w1[j]; }
      }
    }
  }
  __syncthreads();
#pragma unroll
  for (int t = 0; t < 16; ++t) { float2 o; o.x = acc0[t]; o.y = acc1[t]; *(float2*)(Cs + t * 516 + 2 * tid) = o; }
  __syncthreads();
  const int lane = tid & 63, w = tid >> 6;
  const float* lg = p.in[14] + l * 512 + lane * 8;
  const float* lb = p.in[15] + l * 512 + lane * 8;
  bf16_t* AA = (bf16_t*)(p.ws + OFF_ACTA);
#pragma unroll
  for (int tt = 0; tt < 4; ++tt) {
    const int t = w * 4 + tt;
    float x[8];
    float4 xa = *(const float4*)(Cs + t * 516 + lane * 8), xb = *(const float4*)(Cs + t * 516 + lane * 8 + 4);
    x[0] = xa.x; x[1] = xa.y; x[2] = xa.z; x[3] = xa.w; x[4] = xb.x; x[5] = xb.y; x[6] = xb.z; x[7] = xb.w;
    float sm = 0.f;
    for (int j = 0; j < 8; ++j) sm += x[j];
    for (int o = 32; o > 0; o >>= 1) sm += __shfl_xor(sm, o);
    const float mu = sm * (1.f / 512.f);
    float vs = 0.f;
    for (int j = 0; j < 8; ++j) { x[j] -= mu; vs += x[j] * x[j]; }
    for (int o = 32; o > 0; o >>= 1) vs += __shfl_xor(vs, o);
    const float rn = rsqrtf(vs * (1.f / 512.f) + 1e-5f);
    float y[8];
    for (int j = 0; j < 8; ++j) y[j] = silu(x[j] * rn * lg[j] + lb[j]);
    *(bf16x8*)(AA + (size_t)(tile0 + t) * 512 + lane * 8) = pack8(y[0], y[1], y[2], y[3], y[4], y[5], y[6], y[7]);
  }
}

DI void qkprep_item(const Params& p, int s, int l, int it, char* smem, int tid) {
  const int lane = tid & 63, w = tid >> 6;
  const bool ctx = it >= 128;
  const int ntok = s == 0 ? 256 : 4096;
  const int M = s == 0 ? 256 : 4352;
  const int coff = s == 0 ? 0 : 256;
  int b, npos0, tok0;
  if (!ctx) { tok0 = it * 64; b = tok0 / ntok; npos0 = coff + (tok0 - b * ntok); }
  else { b = (it - 128) >> 2; tok0 = 0; npos0 = ((it - 128) & 3) * 64; }
  const bf16_t* SC = (const bf16_t*)(p.ws + OFF_SEGC);
  bf16_t* QN = (bf16_t*)(p.ws + OFF_QN);
  bf16_t* KB = (bf16_t*)(p.ws + OFF_KB);
  bf16_t* VT = (bf16_t*)(p.ws + OFF_VT);
  const float* rope = (const float*)(p.ws + OFF_ROPE);
  const int g = lane >> 3, sub = lane & 7;
#pragma unroll 4
  for (int task = w; task < 128; task += 4) {
    const int which = task >> 6, tl = task & 63;
    if (ctx && which == 0) continue;
    float x[8];
    if (!ctx) {
      uint4 raw = *(const uint4*)(SC + (size_t)(tok0 + tl) * 1536 + which * 512 + g * 64 + sub * 8);
      x[0] = bflo(raw.x); x[1] = bfhi(raw.x); x[2] = bflo(raw.y); x[3] = bfhi(raw.y);
      x[4] = bflo(raw.z); x[5] = bfhi(raw.z); x[6] = bflo(raw.w); x[7] = bfhi(raw.w);
      float ss = 0.f;
      for (int j = 0; j < 8; ++j) ss += x[j] * x[j];
      ss += __shfl_xor(ss, 1); ss += __shfl_xor(ss, 2); ss += __shfl_xor(ss, 4);
      const float rn = rsqrtf(ss * (1.f / 64.f) + 1e-6f);
      const float* nw = p.in[which == 0 ? 18 : 19] + l * 64 + sub * 8;
      for (int j = 0; j < 8; ++j) x[j] = x[j] * rn * nw[j];
      if (s == 1) {
        const int pos = (tok0 + tl) & 4095;
        float4 cc = *(const float4*)(rope + pos * 32 + sub * 4), sn = *(const float4*)(rope + 131072 + pos * 32 + sub * 4);
        float c4[4] = {cc.x, cc.y, cc.z, cc.w}, s4[4] = {sn.x, sn.y, sn.z, sn.w};
        for (int q = 0; q < 4; ++q) {
          float x1 = x[2 * q], x2 = x[2 * q + 1];
          x[2 * q] = x1 * c4[q] - x2 * s4[q]; x[2 * q + 1] = x1 * s4[q] + x2 * c4[q];
        }
      }
    } else {
      const float* ck = p.in[2] + ((size_t)(b * 2 + l) * 256 + npos0 + tl) * 512 + g * 64 + sub * 8;
      float4 xa = *(const float4*)ck, xb = *(const float4*)(ck + 4);
      x[0] = xa.x; x[1] = xa.y; x[2] = xa.z; x[3] = xa.w; x[4] = xb.x; x[5] = xb.y; x[6] = xb.z; x[7] = xb.w;
    }
    if (which == 0) {
      *(bf16x8*)(QN + (size_t)(tok0 + tl) * 512 + g * 64 + sub * 8) =
          pack8(x[0] * QSCALE, x[1] * QSCALE, x[2] * QSCALE, x[3] * QSCALE, x[4] * QSCALE, x[5] * QSCALE, x[6] * QSCALE, x[7] * QSCALE);
    } else {
      *(bf16x8*)(KB + ((size_t)(b * 8 + g) * M + npos0 + tl) * 64 + sub * 8) = pack8(x[0], x[1], x[2], x[3], x[4], x[5], x[6], x[7]);
      if (s == 0) {
        float* ok = p.out + OUT_CK + ((size_t)(b * 2 + l) * 256 + (npos0 + tl)) * 512 + g * 64 + sub * 8;
        float4 oa = {x[0], x[1], x[2], x[3]}, ob = {x[4], x[5], x[6], x[7]};
        *(float4*)ok = oa; *(float4*)(ok + 4) = ob;
      }
    }
  }
  bf16_t* Vs = (bf16_t*)smem;
  for (int hd = 0; hd < 4; ++hd) {
    __syncthreads();
#pragma unroll
    for (int i = 0; i < 4; ++i) {
      const int id = tid + 256 * i;
      const int tl = id >> 4, ch = id & 15;
      uint4 raw;
      if (!ctx) {
        raw = *(const uint4*)(SC + (size_t)(tok0 + tl) * 1536 + 1024 + hd * 128 + ch * 8);
        if (s == 0) {
          float* ov = p.out + OUT_CV + ((size_t)(b * 2 + l) * 256 + (npos0 + tl)) * 512 + hd * 128 + ch * 8;
          float4 oa = {bflo(raw.x), bfhi(raw.x), bflo(raw.y), bfhi(raw.y)}, ob = {bflo(raw.z), bfhi(raw.z), bflo(raw.w), bfhi(raw.w)};
          *(float4*)ov = oa; *(float4*)(ov + 4) = ob;
        }
      } else {
        const float* cvp = p.in[3] + ((size_t)(b * 2 + l) * 256 + npos0 + tl) * 512 + hd * 128 + ch * 8;
        float4 xa = *(const float4*)cvp, xb = *(const float4*)(cvp + 4);
        raw.x = pk2(xa.x, xa.y); raw.y = pk2(xa.z, xa.w); raw.z = pk2(xb.x, xb.y); raw.w = pk2(xb.z, xb.w);
      }
      *(uint4*)(Vs + tl * 136 + ch * 8) = raw;
    }
    __syncthreads();
    const int e = tid & 127, half = tid >> 7;
    bf16_t* dstp = VT + ((size_t)(b * 4 + hd) * 128 + e) * M + npos0 + 32 * half;
#pragma unroll
    for (int q = 0; q < 4; ++q) {
      unsigned u[4];
#pragma unroll
      for (int j = 0; j < 4; ++j) {
        unsigned lo = Vs[(32 * half + 8 * q + 2 * j) * 136 + e], hi = Vs[(32 * half + 8 * q + 2 * j + 1) * 136 + e];
        u[j] = lo | (hi << 16);
      }
      uint4 o; o.x = u[0]; o.y = u[1]; o.z = u[2]; o.w = u[3];
      *(uint4*)(dstp + 8 * q) = o;
    }
  }
}

DI void attn_item(const Params& p, int s, int l, int it, char* smem, int tid) {
  const int lane = tid & 63, w = tid >> 6, r = lane & 31, hh = lane >> 5;
  const int c = w >> 1, qsub = w & 1;
  const int ntok = s == 0 ? 256 : 4096;
  const int M = s == 0 ? 256 : 4352;
  const int qbs = ntok >> 6;
  const int qb = it % qbs, bh = it / qbs;
  const int b = bh >> 2, h = bh & 3;
  const int tq = b * ntok + qb * 64 + qsub * 32 + r;
  const bf16_t* QN = (const bf16_t*)(p.ws + OFF_QN);
  const bf16_t* Kg = (const bf16_t*)(p.ws + OFF_KB) + (size_t)bh * 2 * M * 64;
  const bf16_t* Vg = (const bf16_t*)(p.ws + OFF_VT) + (size_t)bh * 128 * M;
  bf16_t* Ks = (bf16_t*)smem;
  bf16x8 bq[4];
#pragma unroll
  for (int ks = 0; ks < 4; ++ks) bq[ks] = *(const bf16x8*)(QN + (size_t)tq * 512 + h * 128 + c * 64 + ks * 16 + hh * 8);
  f32x16 O[4];
  for (int e = 0; e < 4; ++e) O[e] = zero16();
  float mrun = -INFINITY, lrun = 0.f;
  const int nt = M >> 6;
  uint4 rk0, rk1, rk2, rk3, rv0, rv1, rv2, rv3;
  const int ch8 = (tid & 7) * 8;
  const bf16_t* kp0 = Kg + (size_t)((tid >> 3) & 63) * 64 + ch8;
  const bf16_t* kp1 = kp0 + (size_t)M * 64;
  const bf16_t* vp = Vg + (size_t)(tid >> 3) * M + ch8;
#define GLOAD(KT) { \
    rk0 = *(const uint4*)(kp0 + (size_t)(KT) * 4096); rk1 = *(const uint4*)(kp0 + (size_t)(KT) * 4096 + 2048); \
    rk2 = *(const uint4*)(kp1 + (size_t)(KT) * 4096); rk3 = *(const uint4*)(kp1 + (size_t)(KT) * 4096 + 2048); \
    rv0 = *(const uint4*)(vp + (KT) * 64); rv1 = *(const uint4*)(vp + (size_t)32 * M + (KT) * 64); \
    rv2 = *(const uint4*)(vp + (size_t)64 * M + (KT) * 64); rv3 = *(const uint4*)(vp + (size_t)96 * M + (KT) * 64); }
#define VSTORE(E, RV) { uint2 lo_, hi_; lo_.x = RV.x; lo_.y = RV.y; hi_.x = RV.z; hi_.y = RV.w; \
    *(uint2*)(Vs + (E) * 68 + ch8) = lo_; *(uint2*)(Vs + (E) * 68 + ch8 + 4) = hi_; }
  constexpr int AST = 2 * 64 * 72 + 128 * 68;
#define ASTORE(ST) { bf16_t* Kw = Ks + (ST) * AST; bf16_t* Vs = Kw + 2 * 64 * 72; const int key = (tid >> 3) & 63, e = tid >> 3; \
      *(uint4*)(Kw + (key) * 72 + ch8) = rk0; *(uint4*)(Kw + (32 + key) * 72 + ch8) = rk1; \
      *(uint4*)(Kw + (64 + key) * 72 + ch8) = rk2; *(uint4*)(Kw + (96 + key) * 72 + ch8) = rk3; \
      VSTORE(e, rv0); VSTORE(e + 32, rv1); VSTORE(e + 64, rv2); VSTORE(e + 96, rv3); }
  GLOAD(0);
  __syncthreads();
  ASTORE(0);
  if (nt > 1) GLOAD(1);
  __syncthreads();
  for (int kt = 0; kt < nt; ++kt) {
    const bf16_t* Kc = Ks + (kt & 1) * AST;
    const bf16_t* Vc = Kc + 2 * 64 * 72;
    f32x16 S[2];
    const float negm = kt == 0 ? 0.f : -mrun;
    __builtin_amdgcn_s_setprio(1);
#pragma unroll
    for (int kk = 0; kk < 2; ++kk) {
#pragma unroll
      for (int i = 0; i < 16; ++i) S[kk][i] = negm;
#pragma unroll
      for (int ks = 0; ks < 4; ++ks) {
        bf16x8 ka = *(const bf16x8*)(Kc + (c * 64 + kk * 32 + r) * 72 + ks * 16 + hh * 8);
        S[kk] = MFMA(ka, bq[ks], S[kk]);
      }
    }
    __builtin_amdgcn_s_setprio(0);
    float mx = S[0][0];
#pragma unroll
    for (int i = 0; i < 16; ++i) { mx = fmaxf(mx, S[0][i]); mx = fmaxf(mx, S[1][i]); }
    mx = fmaxf(mx, __shfl_xor(mx, 32));
    if (__builtin_amdgcn_ballot_w64(kt == 0 || mx > 8.f) != 0ull) {
      const float dm = fmaxf(mx, 0.f);
      const float mold = kt == 0 ? 0.f : mrun;
      const float mnew = kt == 0 ? mx : mold + dm;
      const float shift = mnew - mold;
      const float alpha = kt == 0 ? 0.f : __builtin_amdgcn_exp2f(-shift);
      mrun = mnew;
      lrun *= alpha;
#pragma unroll
      for (int e = 0; e < 4; ++e)
#pragma unroll
        for (int i = 0; i < 16; ++i) O[e][i] *= alpha;
#pragma unroll
      for (int i = 0; i < 16; ++i) { S[0][i] -= shift; S[1][i] -= shift; }
    }
    f32x2 ps2 = {0.f, 0.f};
#pragma unroll
    for (int i = 0; i < 16; ++i) {
      S[0][i] = __builtin_amdgcn_exp2f(S[0][i]); S[1][i] = __builtin_amdgcn_exp2f(S[1][i]);
      f32x2 t2 = {S[0][i], S[1][i]};
      ps2 += t2;
    }
    lrun += ps2[0] + ps2[1];
    bf16x8 pb[2][2];
    pb[0][0] = PACK_STEP(S[0], 0); pb[0][1] = PACK_STEP(S[0], 1); pb[1][0] = PACK_STEP(S[1], 0); pb[1][1] = PACK_STEP(S[1], 1);
    __builtin_amdgcn_s_setprio(1);
#pragma unroll
    for (int e = 0; e < 4; ++e)
#pragma unroll
      for (int kk = 0; kk < 2; ++kk)
#pragma unroll
        for (int s2 = 0; s2 < 2; ++s2) {
          bf16x8 va = ld_perm(Vc + (e * 32 + r) * 68 + kk * 32 + 16 * s2 + 4 * hh);
          O[e] = MFMA(va, pb[kk][s2], O[e]);
        }
    __builtin_amdgcn_s_setprio(0);
    __builtin_amdgcn_sched_barrier(0);
    if (kt + 1 < nt) {
      ASTORE((kt + 1) & 1);
      if (kt + 2 < nt) GLOAD(kt + 2);
    }
    __syncthreads();
  }
  const float ltot = lrun + __shfl_xor(lrun, 32);
  const float inv = 1.f / ltot;
  float* Xs = (float*)smem;
  __syncthreads();
  if (c == 1) {
#pragma unroll
    for (int e = 0; e < 4; ++e)
#pragma unroll
      for (int i = 0; i < 16; ++i) Xs[(qsub * 64 + e * 16 + i) * 64 + lane] = O[e][i] * inv;
  }
  __syncthreads();
  if (c == 0) {
    const float lam = ((const float*)(p.ws + OFF_MISC))[l];
    float ss = 0.f;
#pragma unroll
    for (int e = 0; e < 4; ++e)
#pragma unroll
      for (int i = 0; i < 16; ++i) {
        float v = O[e][i] * inv - lam * Xs[(qsub * 64 + e * 16 + i) * 64 + lane];
        O[e][i] = v; ss += v * v;
      }
    ss += __shfl_xor(ss, 32);
    const float rn = rsqrtf(ss * (1.f / 128.f) + 1e-6f) * ((const float*)(p.ws + OFF_MISC))[2 + l];
    const float* sl = p.in[21] + l * 128;
    bf16_t* OC = (bf16_t*)(p.ws + OFF_OC) + (size_t)tq * 512 + h * 128;
#pragma unroll
    for (int e = 0; e < 4; ++e)
#pragma unroll
      for (int g4 = 0; g4 < 4; ++g4) {
        const int e0 = e * 32 + 8 * g4 + 4 * hh;
        float4 sw = *(const float4*)(sl + e0);
        uint2 o;
        o.x = pk2(O[e][4 * g4 + 0] * rn * sw.x, O[e][4 * g4 + 1] * rn * sw.y);
        o.y = pk2(O[e][4 * g4 + 2] * rn * sw.z, O[e][4 * g4 + 3] * rn * sw.w);
        *(uint2*)(OC + e0) = o;
      }
  }
}

struct HgrnSmem {
  bf16_t Qs[32 * 136]; bf16_t Ks[32 * 136]; bf16_t KTs[128 * 40]; bf16_t VTs[128 * 40];
  float ebs[128]; float tot[2][128];
  bf16_t raw[3 * 4096];
};
struct HgrnPref { u32x4 z0, z1, q0, q1, v0, v1; };

template <int OUT>
DI void hgrn_prefetch(HgrnPref& pf, const bf16_t* SH, int tk0, int h, int dir, int tid) {
  const bf16_t* g = SH + (size_t)(tk0 + (tid >> 4)) * 2560 + h * 128 + (tid & 15) * 8;
  pf.z0 = *(const u32x4*)(g + 1024 + dir * 512); pf.z1 = *(const u32x4*)(g + 16 * 2560 + 1024 + dir * 512);
  pf.v0 = *(const u32x4*)(g + 512);              pf.v1 = *(const u32x4*)(g + 16 * 2560 + 512);
  if (OUT != 0) { pf.q0 = *(const u32x4*)(g);    pf.q1 = *(const u32x4*)(g + 16 * 2560); }
}

template <int OUT>
DI float hgrn_chunk(const Params& p, HgrnSmem& sm, int s, int l, int tk0, int tkn, int h, int dir, float lbv, f32x16 (&S)[4], HgrnPref& pf, int tid_in) {
  int tid = tid_in;
  asm volatile("" : "+v"(tid));
  int lane = tid & 63, w = tid >> 6, r = lane & 31, hh = lane >> 5;
  int d = tid & 127, half = tid >> 7;
#define REDERIVE { asm volatile("" : "+v"(tid)); lane = tid & 63; w = tid >> 6; r = lane & 31; hh = lane >> 5; d = tid & 127; half = tid >> 7; }
  const bf16_t* SH = (const bf16_t*)(p.ws + OFF_SEGH);
  {
    const int ro = (tid >> 4) * 128 + (tid & 15) * 8;
    *(u32x4*)(sm.raw + ro) = pf.z0; *(u32x4*)(sm.raw + ro + 16 * 128) = pf.z1;
    *(u32x4*)(sm.raw + 8192 + ro) = pf.v0; *(u32x4*)(sm.raw + 8192 + ro + 16 * 128) = pf.v1;
    if (OUT != 0) { *(u32x4*)(sm.raw + 4096 + ro) = pf.q0; *(u32x4*)(sm.raw + 4096 + ro + 16 * 128) = pf.q1; }
  }
  if (tkn >= 0) hgrn_prefetch<OUT>(pf, SH, tkn, h, dir, tid);
  __syncthreads();
  float lf[16], kg[16];
#pragma unroll
  for (int i = 0; i < 16; ++i) {
    const float z = bf2f(sm.raw[(16 * half + i) * 128 + d]);
    const float e = __expf(-z);
    const float sg = __builtin_amdgcn_rcpf(1.f + e);
    const float f = lbv + (1.f - lbv) * sg;
    kg[i] = (1.f - lbv) * e * sg;
    lf[i] = __logf(f);
  }
  float run = 0.f;
  if (dir == 0) {
#pragma unroll
    for (int i = 0; i < 16; ++i) { run += lf[i]; lf[i] = run; }
  } else {
#pragma unroll
    for (int i = 15; i >= 0; --i) { run += lf[i]; lf[i] = run; }
  }
  sm.tot[half][d] = run;
  __syncthreads();
  REDERIVE
  const float t0 = sm.tot[0][d], t1 = sm.tot[1][d];
  const float off = dir == 0 ? (half ? t0 : 0.f) : (half ? 0.f : t1);
  if (half == 0) sm.ebs[d] = __expf(t0 + t1);
#pragma unroll
  for (int g8 = 0; g8 < 2; ++g8) {
    float kt[8], vv[8];
#pragma unroll
    for (int i = 0; i < 8; ++i) {
      const int tl = 16 * half + 8 * g8 + i;
      vv[i] = bf2f(sm.raw[8192 + tl * 128 + d]);
      const float bb = lf[8 * g8 + i] + off;
      kt[i] = kg[8 * g8 + i] * __expf(-bb);
      sm.Ks[tl * 136 + d] = f2bf(kt[i]);
      if (OUT != 0) {
        const float qv = bf2f(sm.raw[4096 + tl * 128 + d]);
        sm.Qs[tl * 136 + d] = f2bf(silu(qv) * __expf(bb));
      }
    }
    *(bf16x8*)(sm.KTs + d * 40 + 16 * half + 8 * g8) = pack8(kt[0], kt[1], kt[2], kt[3], kt[4], kt[5], kt[6], kt[7]);
    *(bf16x8*)(sm.VTs + d * 40 + 16 * half + 8 * g8) = pack8(vv[0], vv[1], vv[2], vv[3], vv[4], vv[5], vv[6], vv[7]);
  }
  __syncthreads();
  REDERIVE
  if (OUT != 0) {
    float* OSC = (float*)(p.ws + osc_off(s));
    __builtin_amdgcn_s_setprio(1);
    f32x16 at = zero16(), at1 = zero16();
#pragma unroll
    for (int ks = 0; ks < 8; ks += 2) {
      bf16x8 ka = *(const bf16x8*)(sm.Ks + r * 136 + ks * 16 + hh * 8);
      bf16x8 qb = *(const bf16x8*)(sm.Qs + r * 136 + ks * 16 + hh * 8);
      at = MFMA(ka, qb, at);
      bf16x8 ka1 = *(const bf16x8*)(sm.Ks + r * 136 + ks * 16 + 16 + hh * 8);
      bf16x8 qb1 = *(const bf16x8*)(sm.Qs + r * 136 + ks * 16 + 16 + hh * 8);
      at1 = MFMA(ka1, qb1, at1);
    }
#pragma unroll
    for (int i = 0; i < 16; ++i) {
      const int srow = crow(i, hh);
      const bool keep = dir == 0 ? (srow <= r) : (srow >= r);
      at[i] = keep ? at[i] + at1[i] : 0.f;
    }
    __builtin_amdgcn_sched_barrier(0);
    f32x16 o = zero16();
#pragma unroll
    for (int s2 = 0; s2 < 2; ++s2) {
      bf16x8 pa = s2 == 0 ? PACK_STEP(at, 0) : PACK_STEP(at, 1);
      bf16x8 vf = ld_perm(sm.VTs + (32 * w + r) * 40 + 16 * s2 + 4 * hh);
      o = MFMA(pa, vf, o);
    }
    __builtin_amdgcn_sched_barrier(0);
    f32x16 o1 = zero16();
#pragma unroll
    for (int dt = 0; dt < 4; ++dt) {
      {
        bf16x8 qa = ld_perm(sm.Qs + r * 136 + 32 * dt + 4 * hh);
        bf16x8 sb = PACK_STEP(S[dt], 0);
        o = MFMA(qa, sb, o);
      }
      {
        bf16x8 qa = ld_perm(sm.Qs + r * 136 + 32 * dt + 16 + 4 * hh);
        bf16x8 sb = PACK_STEP(S[dt], 1);
        o1 = MFMA(qa, sb, o1);
      }
    }
#pragma unroll
    for (int i = 0; i < 16; ++i) o[i] += o1[i];
    __builtin_amdgcn_sched_barrier(0);
    if (OUT == 1) {
#pragma unroll
      for (int i = 0; i < 16; ++i) OSC[(size_t)(tk0 + crow(i, hh)) * 512 + h * 128 + 32 * w + r] = o[i];
    } else {
      bf16_t* OSB = (bf16_t*)(p.ws + osb_off(s));
#pragma unroll
      for (int i = 0; i < 16; ++i) OSB[(size_t)(tk0 + crow(i, hh)) * 512 + h * 128 + 32 * w + r] = f2bf(o[i]);
    }
  }
  __builtin_amdgcn_sched_barrier(0);
  __builtin_amdgcn_s_setprio(1);
  REDERIVE
#pragma unroll
  for (int dt = 0; dt < 4; ++dt) {
#pragma unroll
    for (int ks = 0; ks < 2; ++ks) {
      bf16x8 ka = *(const bf16x8*)(sm.KTs + (32 * dt + r) * 40 + 16 * ks + 8 * hh);
      bf16x8 vb = *(const bf16x8*)(sm.VTs + (32 * w + r) * 40 + 16 * ks + 8 * hh);
      S[dt] = MFMA(ka, vb, S[dt]);
    }
#pragma unroll
    for (int g4 = 0; g4 < 4; ++g4) {
      float4 e4 = *(const float4*)(sm.ebs + 32 * dt + 8 * g4 + 4 * hh);
      S[dt][4 * g4 + 0] *= e4.x; S[dt][4 * g4 + 1] *= e4.y; S[dt][4 * g4 + 2] *= e4.z; S[dt][4 * g4 + 3] *= e4.w;
    }
  }
  __builtin_amdgcn_s_setprio(0);
  return t0 + t1;
}

DI void state_load(f32x16 (&S)[4], const float* base, int w, int r, int hh) {
  const float* q = base + (4 * hh) * 128 + 32 * w + r;
#pragma unroll
  for (int dt = 0; dt < 4; ++dt)
#pragma unroll
    for (int g4 = 0; g4 < 4; ++g4) {
#pragma unroll
      for (int j = 0; j < 4; ++j) S[dt][4 * g4 + j] = q[j * 128];
      q += 1024;
      asm volatile("" : "+v"(q));
    }
}
DI void state_store(const f32x16 (&S)[4], float* base, int w, int r, int hh) {
  float* q = base + (4 * hh) * 128 + 32 * w + r;
#pragma unroll
  for (int dt = 0; dt < 4; ++dt)
#pragma unroll
    for (int g4 = 0; g4 < 4; ++g4) {
#pragma unroll
      for (int j = 0; j < 4; ++j) q[j * 128] = S[dt][4 * g4 + j];
      q += 1024;
      asm volatile("" : "+v"(q));
    }
}
DI void state_scan(f32x16 (&S)[4], const float* base, const float* ebs, int w, int r, int hh) {
  const float* q = base + (4 * hh) * 128 + 32 * w + r;
#pragma unroll
  for (int dt = 0; dt < 4; ++dt) {
    __builtin_amdgcn_sched_barrier(0);
#pragma unroll
    for (int g4 = 0; g4 < 4; ++g4) {
      float4 e4 = *(const float4*)(ebs + 32 * dt + 8 * g4 + 4 * hh);
      S[dt][4 * g4 + 0] = e4.x * S[dt][4 * g4 + 0] + q[0];
      S[dt][4 * g4 + 1] = e4.y * S[dt][4 * g4 + 1] + q[128];
      S[dt][4 * g4 + 2] = e4.z * S[dt][4 * g4 + 2] + q[256];
      S[dt][4 * g4 + 3] = e4.w * S[dt][4 * g4 + 3] + q[384];
      q += 1024;
      asm volatile("" : "+v"(q));
    }
  }
}

DI float hgrn_lb(const Params& p, int l, int dir, int ch) {
  if (l == 0) return 0.f;
  const float* lb = p.in[16];
  float a = lb[(0 * 2 + dir) * 512 + ch], b = lb[(1 * 2 + dir) * 512 + ch];
  return 1.f / (1.f + __expf(a - b));
}

DI void hgrn_pass1_item(const Params& p, int l, int it, char* smem, int tid) {
  HgrnSmem& sm = *(HgrnSmem*)smem;
  const int j = it & 15, dir = (it >> 4) & 1, h = (it >> 5) & 3, b = it >> 7;
  const int lane = tid & 63, w = tid >> 6, r = lane & 31, hh = lane >> 5;
  const int d = tid & 127;
  const bf16_t* SH = (const bf16_t*)(p.ws + OFF_SEGH);
  const float lbv = hgrn_lb(p, l, dir, h * 128 + d);
  f32x16 S[4];
  for (int i = 0; i < 4; ++i) S[i] = zero16();
  float bt = 0.f;
  const int base = b * 4096 + j * 256;
  HgrnPref pf = {};
  hgrn_prefetch<0>(pf, SH, base + (dir == 0 ? 0 : 7) * 32, h, dir, tid);
  __syncthreads();
#pragma unroll 1
  for (int cc = 0; cc < 8; ++cc) {
    const int c = dir == 0 ? cc : 7 - cc;
    const int cn = dir == 0 ? c + 1 : c - 1;
    bt += hgrn_chunk<0>(p, sm, 1, l, base + c * 32, cc < 7 ? base + cn * 32 : -1, h, dir, lbv, S, pf, tid);
  }
  state_store(S, (float*)(p.ws + OFF_SLOC) + (size_t)it * 16384, w, r, hh);
  if (tid < 128) ((float*)(p.ws + OFF_BTOT))[(size_t)it * 128 + d] = bt;
}

DI void hgrn_pass2_item(const Params& p, int s, int l, int it, char* smem, int tid_in) {
  HgrnSmem& sm = *(HgrnSmem*)smem;
  int tid = tid_in;
  asm volatile("" : "+v"(tid));
  const int nj = s == 0 ? 1 : 16;
  const int ntok = s == 0 ? 256 : 4096;
  const int dir = it & 1, it2 = it >> 1;
  const int j = it2 % nj, bh = it2 / nj, h = bh & 3, b = bh >> 2;
  int lane = tid & 63, w = tid >> 6, r = lane & 31, hh = lane >> 5;
  int d = tid & 127;
#define REDERIVE2 { asm volatile("" : "+v"(tid)); lane = tid & 63; w = tid >> 6; r = lane & 31; hh = lane >> 5; d = tid & 127; }
  const bf16_t* SH = (const bf16_t*)(p.ws + OFF_SEGH);
  const float* SLb = (const float*)(p.ws + OFF_SLOC);
  const float* BTb = (const float*)(p.ws + OFF_BTOT);
  const int base = b * ntok + j * 256;
  const float lbv = hgrn_lb(p, l, dir, h * 128 + d);
  HgrnPref pf = {};
  if (dir == 0) hgrn_prefetch<1>(pf, SH, base, h, 0, tid);
  else          hgrn_prefetch<2>(pf, SH, base + 7 * 32, h, 1, tid);
  f32x16 S[4];
  __syncthreads();
  if (s == 0) { for (int i = 0; i < 4; ++i) S[i] = zero16(); }
  else {
    state_load(S, p.in[4] + (size_t)(((b * 2 + l) * 2 + dir) * 4 + h) * 16384, w, r, hh);
    const int nsteps = dir == 0 ? j : 15 - j;
    float* ebt = (float*)sm.raw;
    for (int q = tid; q < nsteps * 128; q += 256) {
      const int st = q >> 7, dd = q & 127;
      const int jj = dir == 0 ? st : 15 - st;
      ebt[q] = __expf(BTb[(size_t)((bh * 2 + dir) * 16 + jj) * 128 + dd]);
    }
    __syncthreads();
#pragma unroll 1
    for (int st = 0; st < nsteps; ++st) {
      REDERIVE2
      const int jj = dir == 0 ? st : 15 - st;
      state_scan(S, SLb + (size_t)((bh * 2 + dir) * 16 + jj) * 16384, ebt + st * 128, w, r, hh);
    }
    __syncthreads();
  }
  if (dir == 0) {
#pragma unroll 1
    for (int c = 0; c < 8; ++c) hgrn_chunk<1>(p, sm, s, l, base + c * 32, c < 7 ? base + (c + 1) * 32 : -1, h, 0, lbv, S, pf, tid);
  } else {
#pragma unroll 1
    for (int c = 7; c >= 0; --c) hgrn_chunk<2>(p, sm, s, l, base + c * 32, c > 0 ? base + (c - 1) * 32 : -1, h, 1, lbv, S, pf, tid);
  }
  if (s == 0) {
    REDERIVE2
    state_store(S, p.out + OUT_ST + (size_t)(((b * 2 + l) * 2 + dir) * 4 + h) * 16384, w, r, hh);
  }
}

DI void hgrn_fin_item(const Params& p, int s, int l, int it, int tid) {
  const int grp = it * 32 + (tid >> 3), sub = tid & 7;
  const int tok = grp >> 2, h = grp & 3;
  const size_t o = (size_t)tok * 512 + h * 128 + 16 * sub;
  const float* of = (const float*)(p.ws + osc_off(s)) + o;
  const bf16_t* ob = (const bf16_t*)(p.ws + osb_off(s)) + o;
  const bf16_t* hgp = (const bf16_t*)(p.ws + OFF_SEGH) + (size_t)tok * 2560 + 2048 + h * 128 + 16 * sub;
  const float* gn = p.in[17] + l * 128 + 16 * sub;
  float x[16];
#pragma unroll
  for (int q = 0; q < 4; ++q) { float4 v = *(const float4*)(of + 4 * q); x[4 * q] = v.x; x[4 * q + 1] = v.y; x[4 * q + 2] = v.z; x[4 * q + 3] = v.w; }
  const u32x4 b0 = *(const u32x4*)ob, b1 = *(const u32x4*)(ob + 8);
  const u32x4 h0 = *(const u32x4*)hgp, h1 = *(const u32x4*)(hgp + 8);
#pragma unroll
  for (int q = 0; q < 4; ++q) { x[2 * q] += bflo(b0[q]); x[2 * q + 1] += bfhi(b0[q]); x[8 + 2 * q] += bflo(b1[q]); x[8 + 2 * q + 1] += bfhi(b1[q]); }
  float ss = 0.f;
#pragma unroll
  for (int j = 0; j < 16; ++j) ss += x[j] * x[j];
  ss += __shfl_xor(ss, 1); ss += __shfl_xor(ss, 2); ss += __shfl_xor(ss, 4);
  const float rn = rsqrtf(ss * (1.f / 128.f) + 1e-6f);
  float y[16];
#pragma unroll
  for (int q = 0; q < 4; ++q) {
    y[2 * q] = x[2 * q] * rn * gn[2 * q] * silu(bflo(h0[q]));             y[2 * q + 1] = x[2 * q + 1] * rn * gn[2 * q + 1] * silu(bfhi(h0[q]));
    y[8 + 2 * q] = x[8 + 2 * q] * rn * gn[8 + 2 * q] * silu(bflo(h1[q])); y[8 + 2 * q + 1] = x[8 + 2 * q + 1] * rn * gn[8 + 2 * q + 1] * silu(bfhi(h1[q]));
  }
  bf16_t* ab = (bf16_t*)(p.ws + OFF_ACTB) + o;
  *(bf16x8*)ab = pack8(y[0], y[1], y[2], y[3], y[4], y[5], y[6], y[7]);
  *(bf16x8*)(ab + 8) = pack8(y[8], y[9], y[10], y[11], y[12], y[13], y[14], y[15]);
}

#define XB_TMO      128
#define XB_XCNT(j)  (256  + 64 * (j))
#define XB_XSUB(j)  (1280 + 64 * (j))
#define XB_XGEN(j)  (2304 + 64 * (j))
#define XB_TOP      3328
#define XB_TOPGEN   3392
#define XCD_BAR_WORDS 3456
#define XB_SPIN_CAP (1u << 22)
#define LAS __attribute__((address_space(3)))
DI unsigned xb_ld(unsigned* p)              { return __hip_atomic_load(p, __ATOMIC_RELAXED, __HIP_MEMORY_SCOPE_AGENT); }
DI unsigned xb_add(unsigned* p, unsigned v) { return __hip_atomic_fetch_add(p, v, __ATOMIC_RELAXED, __HIP_MEMORY_SCOPE_AGENT); }
DI unsigned xb_xcc_id() { return (unsigned)__builtin_amdgcn_s_getreg((3 << 11) | 20) & 0xFu; }
#define XB_SPIN(cond, bar) do { unsigned _sp = 0; while (cond) { __builtin_amdgcn_s_sleep(1); \
    if ((++_sp & 255u) == 0u) { if (xb_ld(&(bar)[XB_TMO])) break; if (_sp > XB_SPIN_CAP) { atomicAdd(&(bar)[XB_TMO], 1u); break; } } } } while (0)
struct XcdBarrier { unsigned* bar; unsigned x; volatile LAS unsigned* st; };
DI XcdBarrier xcd_barrier_post(unsigned* bar, volatile LAS unsigned* st) {
  XcdBarrier b; b.bar = bar; b.x = xb_xcc_id(); b.st = st;
  if (threadIdx.x == 0) (void)xb_add(&bar[XB_XCNT(b.x)], 1u);
  return b;
}
DI void xcd_barrier_complete(unsigned* bar, unsigned x, unsigned& nloc, unsigned& nx) {
  const unsigned G = gridDim.x * gridDim.y * gridDim.z;
  unsigned sum, cnt, mine, sp = 0u;
  for (;;) {
    sum = 0u; cnt = 0u; mine = 0u;
#pragma unroll
    for (unsigned j = 0; j < 16; ++j) { const unsigned c = xb_ld(&bar[XB_XCNT(j)]); sum += c; cnt += (c > 0u) ? 1u : 0u; mine = (j == x) ? c : mine; }
    if (sum == G) break;
    __builtin_amdgcn_s_sleep(1);
    if ((++sp & 255u) == 0u) { if (xb_ld(&bar[XB_TMO])) break; if (sp > XB_SPIN_CAP) { atomicAdd(&bar[XB_TMO], 1u); break; } }
  }
  nloc = mine > 0u ? mine : 1u; nx = cnt > 0u ? cnt : 1u;
}
DI void xcd_barrier(const XcdBarrier& b) {
  asm volatile("s_waitcnt vmcnt(0)" ::: "memory");
  __syncthreads();
  if (threadIdx.x == 0) {
    unsigned* bar = b.bar;
    __builtin_amdgcn_s_waitcnt(0);
    unsigned nloc = b.st[0], nx = b.st[1];
    if (nloc == 0u) { xcd_barrier_complete(bar, b.x, nloc, nx); b.st[0] = nloc; b.st[1] = nx; }
    const unsigned old = xb_add(&bar[XB_XSUB(b.x)], 1u);
    const unsigned gen = old / nloc;
    if (old + 1u == (gen + 1u) * nloc) {
      __builtin_amdgcn_fence(__ATOMIC_RELEASE, "agent");
      asm volatile("s_waitcnt vmcnt(0)" ::: "memory");
      const unsigned og = xb_add(&bar[XB_TOP], 1u);
      const unsigned tg = og / nx;
      if (og + 1u == (tg + 1u) * nx) xb_add(&bar[XB_TOPGEN], 1u);
      else XB_SPIN(xb_ld(&bar[XB_TOPGEN]) == tg, bar);
      __builtin_amdgcn_fence(__ATOMIC_ACQUIRE, "agent");
      xb_add(&bar[XB_XGEN(b.x)], 1u);
      asm volatile("s_waitcnt vmcnt(0)" ::: "memory");
    } else {
      XB_SPIN(xb_ld(&bar[XB_XGEN(b.x)]) == gen, bar);
      __builtin_amdgcn_fence(__ATOMIC_ACQUIRE, "agent");
      asm volatile("s_waitcnt vmcnt(0)" ::: "memory");
    }
  }
  __syncthreads();
}

#define OPQ unsigned zz_ = 0u; asm volatile("" : "+v"(zz_)); int tid = wv64 + (int)__builtin_amdgcn_mbcnt_hi(~0u, __builtin_amdgcn_mbcnt_lo(~0u, zz_)); asm volatile("" : "+v"(tid))

constexpr int NPH = 41;
#ifndef REP
#define REP 0
#endif

__global__ void __launch_bounds__(256, 2) fwd_kernel(Params p, int ph_lo, int ph_hi) {
  __shared__ __attribute__((aligned(16))) char smem[SMEM_BYTES];
  __shared__ uint4 xb_words;
  const int nb = gridDim.x;
  const int wv64 = __builtin_amdgcn_readfirstlane((int)(threadIdx.x & ~63u));
  XcdBarrier xb;
  if (ph_hi - ph_lo > 1) {
    if (threadIdx.x == 0) xb_words = make_uint4(0u, 0u, 0u, 0u);
    __syncthreads();
    xb = xcd_barrier_post((unsigned*)(p.ws + OFF_BAR), (volatile LAS unsigned*)&xb_words);
  }
#if REP
  for (int pp = 2 * ph_lo; pp < 2 * ph_hi; ++pp) {
    const int ph = pp >> 1;
    if ((pp & 1) && (ph == 0 || !((REP >> ((ph - 1) % 10)) & 1))) continue;
#else
  for (int ph = ph_lo; ph < ph_hi; ++ph) {
#endif
    int bid = blockIdx.x;
    asm volatile("" : "+s"(bid));
    if (ph == 0) {
      for (int it = bid; it < 192 + 64 + 1; it += nb) {
        OPQ;
        if (it < 192) mod_item(p, it, smem, tid);
        else if (it < 256) rope_item(p, it - 192, tid);
        else misc_item(p, tid);
      }
    } else {
      const int q = ph - 1;
      const int l = q / 20, s = (q / 10) & 1, k = q % 10;
      if (k == 0 && q != 0) continue;
      switch (k) {
        case 0: {
          for (int it = bid; it < 2048 + 1024; it += nb) {
        OPQ;
            if (it < 2048) norm_item(p, s, l, 0, it, tid);
            else convert_tile(p, 0, it - 2048, smem, tid);
          }
        } break;
        case 1: for (int it = bid; it < 4096; it += nb) { OPQ; gemm1_tile(p, l, it, smem, tid); } break;
        case 2: {
          const int n1 = s == 1 ? 256 : 0;
          const int nq = s == 1 ? 136 : 128;
          const int ncv = (l == 0 && s == 0) ? 1376 : 0;
          if (s == 0) {
            const int ntot = 256 + 512 + nq + ncv;
            unsigned* ctr = (unsigned*)(p.ws + OFF_BAR) + 3600 + 4 * q + 2;
            for (;;) {
              __syncthreads();
              if (threadIdx.x == 0) xb_words.z = atomicAdd(ctr, 1u);
              __syncthreads();
              const int it = (int)xb_words.z;
              if (it >= ntot) break;
        OPQ;
              if (it < 256) hgrn_pass2_item(p, s, l, it, smem, tid);
              else if (it < 256 + nq) qkprep_item(p, s, l, it - 256, smem, tid);
              else if (it < 768 + nq) conv_item(p, s, l, it - 256 - nq, smem, tid);
              else convert_tile(p, 0, 1024 + it - (768 + nq), smem, tid);
            }
          } else
          for (int it = bid; it < n1 + 512 + nq + ncv; it += nb) {
        OPQ;
            if (it < n1) hgrn_pass1_item(p, l, it, smem, tid);
            else if (it < n1 + 512) conv_item(p, s, l, it - n1, smem, tid);
            else if (it < n1 + 512 + nq) qkprep_item(p, s, l, it - n1 - 512, smem, tid);
            else convert_tile(p, 0, 1024 + it - (n1 + 512 + nq), smem, tid);
          }
        } break;
        case 3:
        {
          const int ncv = (l == 0 && s == 0) ? 2400 : 0;
#if REP
          unsigned* ctr = (unsigned*)(p.ws + OFF_BAR) + 3600 + 4 * q + (pp & 1);
#else
          unsigned* ctr = (unsigned*)(p.ws + OFF_BAR) + 3600 + 4 * q;
#endif
          for (;;) {
            __syncthreads();
            if (threadIdx.x == 0) xb_words.z = atomicAdd(ctr, 1u);
            __syncthreads();
            const int it = (int)xb_words.z;
            if (it >= 256 + 512 + ncv) break;
            if (s == 0 && it < 256) continue;
#if REP
            if ((pp & 1) && (REP & 0x10000) && it < 256) continue;
            if ((pp & 1) && (REP & 0x20000) && it >= 256 && it < 768) continue;
#endif
        OPQ;
            if (it < 256) hgrn_pass2_item(p, s, l, it, smem, tid);
            else if (it < 768) attn_item(p, s, l, it - 256, smem, tid);
            else convert_tile(p, 1, it - 768, smem, tid);
          }
        }
          break;
        case 4: for (int it = bid; it < 1024; it += nb) { OPQ; hgrn_fin_item(p, s, l, it, tid); } break;
        case 5: for (int it = bid; it < 512; it += nb) { OPQ; branch_tile(p, l, it, smem, tid); } break;
        case 6: for (int it = bid; it < 512; it += nb) { OPQ; resid_tile(p, s, l, 0, it, smem, tid); } break;
        case 7: for (int it = bid; it < 2048; it += nb) { OPQ; norm_item(p, s, l, 1, it, tid); } break;
        case 8: for (int it = bid; it < 64 * 44; it += nb) { OPQ; ffnin_tile(p, l, it, smem, tid); } break;
        case 9: {
          const int nn = (q < 30) ? 2048 : 0;
          const int s2 = s ^ 1, l2 = l + s;
          for (int it = bid; it < 512 + nn; it += nb) {
        OPQ;
            if (it < 512) resid_tile(p, s, l, 1, it, smem, tid);
            else norm_item(p, s2, l2, 0, it - 512, tid);
          }
        } break;
      }
    }
#if REP
    if (pp + 1 < 2 * ph_hi) {
#else
    if (ph + 1 < ph_hi) {
#endif
      if (ph_hi > 100000) cg::this_grid().sync();
      xcd_barrier(xb);
    }
  }
}

extern "C" void kernel_launch(void* const* d_in, const int* in_sizes, int n_in, void* d_out, int out_size, void* d_ws, size_t ws_size,
                              hipStream_t stream) {
  static int grid_blocks = 0;
  if (!grid_blocks) {
    int dev = 0, cus = 0, per_cu = 0;
    hipGetDevice(&dev);
    hipDeviceGetAttribute(&cus, hipDeviceAttributeMultiprocessorCount, dev);
    hipOccupancyMaxActiveBlocksPerMultiprocessor(&per_cu, fwd_kernel, 256, 0);
    if (per_cu < 1) per_cu = 1;
    if (per_cu > 2) per_cu = 2;
    grid_blocks = cus * per_cu;
  }
  if (ws_size < WS_END) { fprintf(stderr, "workspace too small: %zu < %zu\n", ws_size, (size_t)WS_END); return; }
  Params p{};
  for (int i = 0; i < 26; ++i) p.in[i] = (const float*)d_in[i];
  p.out = (float*)d_out;
  p.ws = (char*)d_ws;
#if MEGA
  hipMemsetAsync((char*)d_ws + OFF_BAR, 0, 16384, stream);
  int lo = 0, hi = NPH;
  void* args[] = {&p, &lo, &hi};
  hipError_t e = hipLaunchCooperativeKernel((void*)fwd_kernel, dim3(grid_blocks), dim3(256), args, 0, stream);
  if (e != hipSuccess) fprintf(stderr, "cooperative launch failed: %s (grid %d)\n", hipGetErrorString(e), grid_blocks);
#else
  for (int ph = 0; ph < NPH; ++ph) fwd_kernel<<<grid_blocks, 256, 0, stream>>>(p, ph, ph + 1);
#endif
}
```

```cpp
#include <hip/hip_runtime.h>
#include <hip/hip_cooperative_groups.h>
#include <cstdio>
namespace cg = cooperative_groups;

#ifndef MEGA
#define MEGA 1
#endif

#define DI __device__ __forceinline__
typedef unsigned short bf16_t;
typedef __attribute__((ext_vector_type(8))) short bf16x8;
typedef __attribute__((ext_vector_type(4))) short s16x4;
typedef __attribute__((ext_vector_type(16))) float f32x16;
typedef __attribute__((ext_vector_type(2))) float f32x2;
typedef __attribute__((ext_vector_type(4))) unsigned u32x4;
typedef __attribute__((ext_vector_type(2))) __bf16 bf16x2_t;
#define MFMA(a, b, c) __builtin_amdgcn_mfma_f32_32x32x16_bf16((a), (b), (c), 0, 0, 0)

DI unsigned pk2(float a, float b) { f32x2 v = {a, b}; return __builtin_bit_cast(unsigned, __builtin_convertvector(v, bf16x2_t)); }
DI bf16_t f2bf(float a) { return (bf16_t)(pk2(a, 0.f) & 0xffffu); }
DI float bf2f(bf16_t v) { return __uint_as_float(((unsigned)v) << 16); }
DI float bflo(unsigned u) { return __uint_as_float(u << 16); }
DI float bfhi(unsigned u) { return __uint_as_float(u & 0xffff0000u); }
DI float sigm(float x) { return __builtin_amdgcn_rcpf(1.f + __expf(-x)); }
DI float silu(float x) { return x * __builtin_amdgcn_rcpf(1.f + __expf(-x)); }
DI bf16x8 pack8(float a0, float a1, float a2, float a3, float a4, float a5, float a6, float a7) {
  uint4 u; u.x = pk2(a0, a1); u.y = pk2(a2, a3); u.z = pk2(a4, a5); u.w = pk2(a6, a7);
  return __builtin_bit_cast(bf16x8, u);
}
#define PACK_STEP(x, s) pack8(x[8*(s)+0], x[8*(s)+1], x[8*(s)+2], x[8*(s)+3], x[8*(s)+4], x[8*(s)+5], x[8*(s)+6], x[8*(s)+7])
DI bf16x8 ld_perm(const bf16_t* p) {
  s16x4 lo = *(const s16x4*)p; s16x4 hi = *(const s16x4*)(p + 8);
  return __builtin_shufflevector(lo, hi, 0, 1, 2, 3, 4, 5, 6, 7);
}
DI int crow(int i, int hh) { return (i & 3) + 8 * (i >> 2) + 4 * hh; }
DI f32x16 zero16() { f32x16 z; for (int i = 0; i < 16; ++i) z[i] = 0.f; return z; }

constexpr int TOK = 8192;
constexpr int DFF = 2816;
constexpr size_t alignup(size_t x) { return (x + 255) & ~(size_t)255; }
constexpr size_t OFF_WIN  = 0;
constexpr size_t OFF_WBR  = OFF_WIN  + (size_t)8192 * 1024 * 2;
constexpr size_t OFF_WOUT = OFF_WBR  + (size_t)1024 * 1536 * 2;
constexpr size_t OFF_WFI  = OFF_WOUT + (size_t)1024 * 1024 * 2;
constexpr size_t OFF_WFO  = OFF_WFI  + (size_t)5632 * 1024 * 2;
constexpr size_t WSET     = OFF_WFO  + (size_t)1024 * 2816 * 2;
constexpr size_t OFF_MOD  = 2 * WSET;
constexpr size_t OFF_MISC = OFF_MOD  + (size_t)2 * 3 * 6144 * 4;
constexpr size_t OFF_ROPE = OFF_MISC + 4096;
constexpr size_t OFF_H    = OFF_ROPE + (size_t)4096 * 32 * 2 * 4;
constexpr size_t OFF_SEGA = OFF_H    + (size_t)TOK * 1024 * 2;
constexpr size_t OFF_SEGH = OFF_SEGA + (size_t)TOK * 1024 * 2;
constexpr size_t OFF_SEGC = OFF_SEGH + (size_t)TOK * 2560 * 2;
constexpr size_t OFF_SEGG = OFF_SEGC + (size_t)TOK * 1536 * 2;
constexpr size_t OFF_QN   = OFF_SEGG + (size_t)TOK * 3072 * 2;
constexpr size_t OFF_KB   = OFF_QN   + (size_t)TOK * 512 * 2;
constexpr size_t OFF_VT   = OFF_KB   + (size_t)2 * 4 * 2 * 4352 * 64 * 2;
constexpr size_t OFF_ACTA = OFF_VT   + (size_t)2 * 4 * 128 * 4352 * 2;
constexpr size_t OFF_SLOC = OFF_ACTA + (size_t)TOK * 512 * 2;
constexpr size_t OFF_BTOT = OFF_SLOC + (size_t)2 * 4 * 2 * 16 * 16384 * 4;
constexpr size_t OFF_BAR  = OFF_BTOT + (size_t)2 * 4 * 2 * 16 * 128 * 4;
constexpr size_t WS_END   = OFF_BAR + 16384;
constexpr size_t OFF_ACTB = OFF_SEGA;
constexpr size_t OFF_OC   = OFF_SEGC;
constexpr size_t OFF_OSC  = OFF_SEGC + (size_t)TOK * 512 * 2;
constexpr size_t OFF_OSB  = OFF_SEGA + (size_t)TOK * 512 * 2;
DI size_t osc_off(int s) { return s == 0 ? OFF_H : OFF_OSC; }
DI size_t osb_off(int s) { return s == 0 ? OFF_SLOC : OFF_OSB; }
constexpr size_t OFF_M    = OFF_H;
constexpr size_t OFF_FF   = OFF_SEGG;

constexpr size_t OUT_CK = (size_t)2 * TOK * 1024;
constexpr size_t OUT_CV = OUT_CK + (size_t)32 * 2 * 256 * 512;
constexpr size_t OUT_ST = OUT_CV + (size_t)32 * 2 * 256 * 512;

constexpr float QSCALE = 0.125f * 1.4426950408889634f;

struct Params { const float* in[26]; float* out; char* ws; };

constexpr int SMEM_BYTES = 73728;

constexpr int GST = 128 * 72;
template <bool DEEP>
DI void gemm_main(f32x16 (&acc)[2][2], const bf16_t* a0, size_t lda32, const bf16_t* b0, const bf16_t* b1, const bf16_t* b2, const bf16_t* b3,
                  int nk, bf16_t* sA, bf16_t* sB, int tid) {
  const int lane = tid & 63, w = tid >> 6, wm = w >> 1, wn = w & 1, r = lane & 31, hh = lane >> 5;
  const int so = (tid >> 3) * 72 + (tid & 7) * 8;
  const bf16_t* a1 = a0 + lda32; const bf16_t* a2 = a1 + lda32; const bf16_t* a3 = a2 + lda32;
  u32x4 pa0, pa1, pa2, pa3, pb0, pb1, pb2, pb3;
  u32x4 qa0, qa1, qa2, qa3, qb0, qb1, qb2, qb3;
#define GLD_P(OFF) { pa0 = *(const u32x4*)(a0 + (OFF)); pa1 = *(const u32x4*)(a1 + (OFF)); pa2 = *(const u32x4*)(a2 + (OFF)); pa3 = *(const u32x4*)(a3 + (OFF)); \
                     pb0 = *(const u32x4*)(b0 + (OFF)); pb1 = *(const u32x4*)(b1 + (OFF)); pb2 = *(const u32x4*)(b2 + (OFF)); pb3 = *(const u32x4*)(b3 + (OFF)); }
#define GLD_Q(OFF) { qa0 = *(const u32x4*)(a0 + (OFF)); qa1 = *(const u32x4*)(a1 + (OFF)); qa2 = *(const u32x4*)(a2 + (OFF)); qa3 = *(const u32x4*)(a3 + (OFF)); \
                     qb0 = *(const u32x4*)(b0 + (OFF)); qb1 = *(const u32x4*)(b1 + (OFF)); qb2 = *(const u32x4*)(b2 + (OFF)); qb3 = *(const u32x4*)(b3 + (OFF)); }
#define LST_P(ST) { bf16_t* nA_ = sA + (ST) * GST + so; bf16_t* nB_ = sB + (ST) * GST + so; \
    *(u32x4*)(nA_) = pa0; *(u32x4*)(nA_ + 32 * 72) = pa1; *(u32x4*)(nA_ + 64 * 72) = pa2; *(u32x4*)(nA_ + 96 * 72) = pa3; \
    *(u32x4*)(nB_) = pb0; *(u32x4*)(nB_ + 32 * 72) = pb1; *(u32x4*)(nB_ + 64 * 72) = pb2; *(u32x4*)(nB_ + 96 * 72) = pb3; }
#define LST_Q(ST) { bf16_t* nA_ = sA + (ST) * GST + so; bf16_t* nB_ = sB + (ST) * GST + so; \
    *(u32x4*)(nA_) = qa0; *(u32x4*)(nA_ + 32 * 72) = qa1; *(u32x4*)(nA_ + 64 * 72) = qa2; *(u32x4*)(nA_ + 96 * 72) = qa3; \
    *(u32x4*)(nB_) = qb0; *(u32x4*)(nB_ + 32 * 72) = qb1; *(u32x4*)(nB_ + 64 * 72) = qb2; *(u32x4*)(nB_ + 96 * 72) = qb3; }
#define GCOMPUTE(ST) { const bf16_t* cA = sA + (ST) * GST + (wm * 64 + r) * 72 + hh * 8; const bf16_t* cB = sB + (ST) * GST + (wn * 64 + r) * 72 + hh * 8; \
  if (DEEP) { \
    bf16x8 fa0[4], fa1[4], fb0[4], fb1[4]; \
    _Pragma("unroll") for (int ks = 0; ks < 4; ++ks) { \
      fa0[ks] = *(const bf16x8*)(cA + ks * 16); fa1[ks] = *(const bf16x8*)(cA + 32 * 72 + ks * 16); \
      fb0[ks] = *(const bf16x8*)(cB + ks * 16); fb1[ks] = *(const bf16x8*)(cB + 32 * 72 + ks * 16); } \
    __builtin_amdgcn_sched_barrier(0); \
    _Pragma("unroll") for (int ks = 0; ks < 4; ++ks) { \
      acc[0][0] = MFMA(fa0[ks], fb0[ks], acc[0][0]); acc[0][1] = MFMA(fa0[ks], fb1[ks], acc[0][1]); \
      acc[1][0] = MFMA(fa1[ks], fb0[ks], acc[1][0]); acc[1][1] = MFMA(fa1[ks], fb1[ks], acc[1][1]); } \
  } else { \
    __builtin_amdgcn_s_setprio(1); \
    _Pragma("unroll") for (int ks = 0; ks < 4; ++ks) { \
      bf16x8 fa0 = *(const bf16x8*)(cA + ks * 16), fa1 = *(const bf16x8*)(cA + 32 * 72 + ks * 16); \
      bf16x8 fb0 = *(const bf16x8*)(cB + ks * 16), fb1 = *(const bf16x8*)(cB + 32 * 72 + ks * 16); \
      acc[0][0] = MFMA(fa0, fb0, acc[0][0]); acc[0][1] = MFMA(fa0, fb1, acc[0][1]); \
      acc[1][0] = MFMA(fa1, fb0, acc[1][0]); acc[1][1] = MFMA(fa1, fb1, acc[1][1]); } \
    __builtin_amdgcn_s_setprio(0); } }
  GLD_P(0);
  __syncthreads();
  LST_P(0);
  if (!DEEP) {
    __syncthreads();
    for (int kt = 0; kt < nk; kt += 2) {
      GLD_P((size_t)(kt + 1) * 64);
      GCOMPUTE(0);
      LST_P(1);
      __syncthreads();
      const bool m2 = kt + 2 < nk;
      if (m2) GLD_P((size_t)(kt + 2) * 64);
      GCOMPUTE(1);
      if (m2) LST_P(0);
      __syncthreads();
    }
    return;
  }
  GLD_P(64);
  __syncthreads();
  for (int kt = 0; kt < nk; kt += 2) {
    const bool m2 = kt + 2 < nk;
    const size_t o2 = (size_t)(kt + 2) * 64;
    if (m2) GLD_Q(o2);
    __builtin_amdgcn_sched_barrier(0);
    GCOMPUTE(0);
    __builtin_amdgcn_sched_barrier(0);
    LST_P(1);
    __syncthreads();
    if (m2) GLD_P(o2 + 64);
    __builtin_amdgcn_sched_barrier(0);
    GCOMPUTE(1);
    __builtin_amdgcn_sched_barrier(0);
    if (m2) LST_Q(0);
    __syncthreads();
  }
#undef GLD_P
#undef GLD_Q
#undef LST_P
#undef LST_Q
#undef GCOMPUTE
}

DI void convert_tile(const Params& p, int layer, int t, char* smem, int tid) {
  const float* src; bf16_t* dst; int K, N;
  char* wb = p.ws + (size_t)layer * WSET;
  if (t < 1024)      { src = p.in[11] + (size_t)layer * 1024 * 8192; dst = (bf16_t*)(wb + OFF_WIN);  K = 1024; N = 8192; }
  else if (t < 1216) { t -= 1024; src = p.in[22] + (size_t)layer * 1536 * 1024; dst = (bf16_t*)(wb + OFF_WBR);  K = 1536; N = 1024; }
  else if (t < 1344) { t -= 1216; src = p.in[23] + (size_t)layer * 1024 * 1024; dst = (bf16_t*)(wb + OFF_WOUT); K = 1024; N = 1024; }
  else if (t < 2048) { t -= 1344; src = p.in[24] + (size_t)layer * 1024 * 5632; dst = (bf16_t*)(wb + OFF_WFI);  K = 1024; N = 5632; }
  else               { t -= 2048; src = p.in[25] + (size_t)layer * 2816 * 1024; dst = (bf16_t*)(wb + OFF_WFO);  K = 2816; N = 1024; }
  const int tn = N >> 8;
  const int n0 = (t % tn) * 256, k0 = (t / tn) * 32;
  float* T = (float*)smem;
  __syncthreads();
  {
    const float* sp = src + (size_t)(k0 + (tid >> 6)) * N + n0 + (tid & 63) * 4;
    float4 v[8];
#pragma unroll
    for (int i = 0; i < 8; ++i) v[i] = *(const float4*)(sp + (size_t)(i * 4) * N);
#pragma unroll
    for (int i = 0; i < 8; ++i) *(float4*)(T + (i * 4 + (tid >> 6)) * 260 + (tid & 63) * 4) = v[i];
  }
  __syncthreads();
  {
    float x[32];
#pragma unroll
    for (int k = 0; k < 32; ++k) x[k] = T[k * 260 + tid];
    bf16_t* dp = dst + (size_t)(n0 + tid) * K + k0;
#pragma unroll
    for (int q = 0; q < 4; ++q)
      *(bf16x8*)(dp + 8 * q) = pack8(x[8 * q], x[8 * q + 1], x[8 * q + 2], x[8 * q + 3], x[8 * q + 4], x[8 * q + 5], x[8 * q + 6], x[8 * q + 7]);
  }
}

DI void mod_item(const Params& p, int it, char* smem, int tid) {
  const int l = it / 96, chunk = it % 96;
  const int lane = tid & 63, w = tid >> 6;
  const int n = chunk * 64 + lane;
  const float* wm = p.in[7] + (size_t)l * 1024 * 6144;
  const float* c0 = p.in[6]; const float* c1 = p.in[5]; const float* c2 = p.in[5] + 1024;
  float a0 = 0.f, a1 = 0.f, a2 = 0.f;
#pragma unroll 32
  for (int k = w * 256; k < w * 256 + 256; ++k) {
    float wv = wm[(size_t)k * 6144 + n];
    a0 += silu(c0[k]) * wv; a1 += silu(c1[k]) * wv; a2 += silu(c2[k]) * wv;
  }
  float* red = (float*)smem;
  __syncthreads();
  red[(w * 3 + 0) * 64 + lane] = a0; red[(w * 3 + 1) * 64 + lane] = a1; red[(w * 3 + 2) * 64 + lane] = a2;
  __syncthreads();
  if (tid < 192) {
    int cv = tid >> 6;
    float s = red[(0 * 3 + cv) * 64 + lane] + red[(1 * 3 + cv) * 64 + lane] + red[(2 * 3 + cv) * 64 + lane] + red[(3 * 3 + cv) * 64 + lane];
    float* mod = (float*)(p.ws + OFF_MOD);
    mod[(size_t)(l * 3 + cv) * 6144 + n] = s + p.in[8][l * 6144 + n];
  }
}
DI void rope_item(const Params& p, int it, int tid) {
  float* rc = (float*)(p.ws + OFF_ROPE);
#pragma unroll
  for (int j = 0; j < 8; ++j) {
    int idx = it * 2048 + tid * 8 + j;
    int pos = idx >> 5, i = idx & 31;
    float inv = exp2f(-(float)(i & 15) * (13.287712379549449f / 16.f));
    float ang = (float)(i < 16 ? (pos >> 6) : (pos & 63)) * inv;
    rc[idx] = cosf(ang); rc[131072 + idx] = sinf(ang);
  }
}
DI void misc_item(const Params& p, int tid) {
  if (tid < 64) {
    for (int l = 0; l < 2; ++l) {
      const float* lq = p.in[20] + l * 256;
      float a = lq[tid] * lq[64 + tid], b = lq[128 + tid] * lq[192 + tid];
      for (int o = 32; o > 0; o >>= 1) { a += __shfl_xor(a, o); b += __shfl_xor(b, o); }
      if (tid == 0) {
        float lam_init = 0.8f - 0.6f * expf(-0.3f * (float)l);
        ((float*)(p.ws + OFF_MISC))[l] = expf(a) - expf(b) + lam_init;
        ((float*)(p.ws + OFF_MISC))[2 + l] = 1.f - lam_init;
      }
    }
  }
}

DI void norm_item(const Params& p, int s, int l, int which, int it, int tid) {
  const int lane = tid & 63, w = tid >> 6;
  const int row0 = it * 16 + w * 4;
  const float* x;
  if (which == 0 && l == 0) x = p.in[s] + (size_t)row0 * 1024;
  else x = p.out + ((size_t)s * TOK + row0) * 1024;
  const int cv = s == 0 ? 0 : 1 + (row0 >> 12);
  const float* mod = (const float*)(p.ws + OFF_MOD) + (size_t)(l * 3 + cv) * 6144 + which * 3072;
  const float* g = p.in[which == 0 ? 9 : 10] + l * 1024;
  float4 v[4][4]; float ss[4] = {0.f, 0.f, 0.f, 0.f};
#pragma unroll
  for (int j = 0; j < 4; ++j)
#pragma unroll
    for (int i = 0; i < 4; ++i) v[j][i] = *(const float4*)(x + j * 1024 + 4 * (lane + 64 * i));
#pragma unroll
  for (int j = 0; j < 4; ++j)
#pragma unroll
    for (int i = 0; i < 4; ++i) ss[j] += v[j][i].x * v[j][i].x + v[j][i].y * v[j][i].y + v[j][i].z * v[j][i].z + v[j][i].w * v[j][i].w;
#pragma unroll
  for (int j = 0; j < 4; ++j) {
    for (int o = 32; o > 0; o >>= 1) ss[j] += __shfl_xor(ss[j], o);
    ss[j] = rsqrtf(ss[j] * (1.f / 1024.f) + 1e-6f);
  }
  bf16_t* h = (bf16_t*)(p.ws + OFF_H) + (size_t)row0 * 1024;
#pragma unroll
  for (int i = 0; i < 4; ++i) {
    const int c = 4 * (lane + 64 * i);
    const float4 gg = *(const float4*)(g + c), sh = *(const float4*)(mod + c), sc = *(const float4*)(mod + 1024 + c);
    const float m0 = gg.x * (1.f + sc.x), m1 = gg.y * (1.f + sc.y), m2 = gg.z * (1.f + sc.z), m3 = gg.w * (1.f + sc.w);
#pragma unroll
    for (int j = 0; j < 4; ++j) {
      const float rn = ss[j];
      uint2 o;
      o.x = pk2(v[j][i].x * rn * m0 + sh.x, v[j][i].y * rn * m1 + sh.y);
      o.y = pk2(v[j][i].z * rn * m2 + sh.z, v[j][i].w * rn * m3 + sh.w);
      *(uint2*)(h + j * 1024 + c) = o;
    }
  }
}

DI void gemm1_tile(const Params& p, int l, int t, char* smem, int tid) {
  const int nb = t & 63, mb = t >> 6;
  const int m0 = mb * 128, n0 = nb * 128;
  const bf16_t* A = (const bf16_t*)(p.ws + OFF_H);
  const bf16_t* B = (const bf16_t*)(p.ws + (size_t)l * WSET + OFF_WIN);
  bf16_t* sA = (bf16_t*)smem; bf16_t* sB = sA + 2 * GST;
  f32x16 acc[2][2];
  for (int a = 0; a < 2; ++a) for (int b = 0; b < 2; ++b) acc[a][b] = zero16();
  const int lr = tid >> 3, kc = (tid & 7) * 8;
  {
    const bf16_t* bp = B + (unsigned)((n0 + lr) * 1024 + kc);
    gemm_main<false>(acc, A + (unsigned)((m0 + lr) * 1024 + kc), (size_t)32 * 1024, bp, bp + 32 * 1024, bp + 64 * 1024, bp + 96 * 1024, 16, sA, sB, tid);
  }
  bf16_t* dst; int ld, c0;
  if (n0 < 1024)      { dst = (bf16_t*)(p.ws + OFF_SEGA); ld = 1024; c0 = n0; }
  else if (n0 < 3584) { dst = (bf16_t*)(p.ws + OFF_SEGH); ld = 2560; c0 = n0 - 1024; }
  else if (n0 < 5120) { dst = (bf16_t*)(p.ws + OFF_SEGC); ld = 1536; c0 = n0 - 3584; }
  else                { dst = (bf16_t*)(p.ws + OFF_SEGG); ld = 3072; c0 = n0 - 5120; }
  const int lane = tid & 63, w = tid >> 6, wm = w >> 1, wn = w & 1, r = lane & 31, hh = lane >> 5;
  bf16_t* Gs = (bf16_t*)smem;
#pragma unroll
  for (int mi = 0; mi < 2; ++mi)
#pragma unroll
    for (int ni = 0; ni < 2; ++ni)
#pragma unroll
      for (int i = 0; i < 16; ++i)
        Gs[(wm * 64 + mi * 32 + crow(i, hh)) * 136 + wn * 64 + ni * 32 + r] = f2bf(acc[mi][ni][i]);
  __syncthreads();
  {
    const int grow = tid >> 4, gc8 = (tid & 15) * 8;
#pragma unroll
    for (int i = 0; i < 8; ++i)
      *(u32x4*)(dst + (unsigned)((m0 + grow + 16 * i) * ld + c0 + gc8)) = *(const u32x4*)(Gs + (grow + 16 * i) * 136 + gc8);
  }
}

DI void branch_tile(const Params& p, int l, int t, char* smem, int tid) {
  const int nb = t & 7, mb = t >> 3;
  const int m0 = mb * 128, n0 = nb * 128;
  bf16_t* sA = (bf16_t*)smem; bf16_t* sB = sA + 2 * GST;
  bf16_t* Gs = (bf16_t*)smem;
  const bf16_t* B = (const bf16_t*)(p.ws + (size_t)l * WSET + OFF_WBR);
  const bf16_t* G = (const bf16_t*)(p.ws + OFF_SEGG);
  const int lr = tid >> 3, kc = (tid & 7) * 8;
  const int lane = tid & 63, w = tid >> 6, wm = w >> 1, wn = w & 1, r = lane & 31, hh = lane >> 5;
  const int grow = tid >> 4, gc8 = (tid & 15) * 8;
  f32x16 tot[2][2];
  for (int a = 0; a < 2; ++a) for (int b = 0; b < 2; ++b) tot[a][b] = zero16();
#pragma unroll 1
  for (int br = 0; br < 3; ++br) {
    const bf16_t* A = (const bf16_t*)(p.ws + (br == 0 ? OFF_ACTA : (br == 1 ? OFF_ACTB : OFF_OC)));
    u32x4 gq0, gq1, gq2, gq3, gq4, gq5, gq6, gq7;
    {
      const bf16_t* gp = G + (unsigned)((m0 + grow) * 3072 + br * 1024 + n0 + gc8);
      gq0 = *(const u32x4*)(gp);             gq1 = *(const u32x4*)(gp + 16 * 3072); gq2 = *(const u32x4*)(gp + 32 * 3072); gq3 = *(const u32x4*)(gp + 48 * 3072);
      gq4 = *(const u32x4*)(gp + 64 * 3072); gq5 = *(const u32x4*)(gp + 80 * 3072); gq6 = *(const u32x4*)(gp + 96 * 3072); gq7 = *(const u32x4*)(gp + 112 * 3072);
    }
    f32x16 acc[2][2];
    for (int a = 0; a < 2; ++a) for (int b = 0; b < 2; ++b) acc[a][b] = zero16();
    {
      const bf16_t* bp = B + (unsigned)((n0 + lr) * 1536 + br * 512 + kc);
      gemm_main<false>(acc, A + (unsigned)((m0 + lr) * 512 + kc), (size_t)32 * 512, bp, bp + 32 * 1536, bp + 64 * 1536, bp + 96 * 1536, 8, sA, sB, tid);
    }
    {
      bf16_t* gs = Gs + grow * 136 + gc8;
      *(u32x4*)(gs) = gq0;            *(u32x4*)(gs + 16 * 136) = gq1; *(u32x4*)(gs + 32 * 136) = gq2; *(u32x4*)(gs + 48 * 136) = gq3;
      *(u32x4*)(gs + 64 * 136) = gq4; *(u32x4*)(gs + 80 * 136) = gq5; *(u32x4*)(gs + 96 * 136) = gq6; *(u32x4*)(gs + 112 * 136) = gq7;
    }
    __syncthreads();
#pragma unroll
    for (int mi = 0; mi < 2; ++mi)
#pragma unroll
      for (int ni = 0; ni < 2; ++ni)
#pragma unroll
        for (int i = 0; i < 16; ++i) {
          const float gte = bf2f(Gs[(wm * 64 + mi * 32 + crow(i, hh)) * 136 + wn * 64 + ni * 32 + r]);
          tot[mi][ni][i] += sigm(gte) * acc[mi][ni][i];
        }
  }
  __syncthreads();
#pragma unroll
  for (int mi = 0; mi < 2; ++mi)
#pragma unroll
    for (int ni = 0; ni < 2; ++ni)
#pragma unroll
      for (int i = 0; i < 16; ++i)
        Gs[(wm * 64 + mi * 32 + crow(i, hh)) * 136 + wn * 64 + ni * 32 + r] = f2bf(tot[mi][ni][i]);
  __syncthreads();
  bf16_t* M = (bf16_t*)(p.ws + OFF_M);
#pragma unroll
  for (int i = 0; i < 8; ++i)
    *(u32x4*)(M + (unsigned)((m0 + grow + 16 * i) * 1024 + n0 + gc8)) = *(const u32x4*)(Gs + (grow + 16 * i) * 136 + gc8);
}

DI void resid_tile(const Params& p, int s, int l, int which, int t, char* smem, int tid) {
  const int nb = t & 7, mb = t >> 3;
  const int m0 = mb * 128, n0 = nb * 128;
  bf16_t* sA = (bf16_t*)smem; bf16_t* sB = sA + 2 * GST;
  const int K = which == 0 ? 1024 : DFF;
  const bf16_t* A = (const bf16_t*)(p.ws + (which == 0 ? OFF_M : OFF_FF));
  const bf16_t* B = (const bf16_t*)(p.ws + (size_t)l * WSET + (which == 0 ? OFF_WOUT : OFF_WFO));
  const int lr = tid >> 3, kc = (tid & 7) * 8;
  f32x16 acc[2][2];
  for (int a = 0; a < 2; ++a) for (int b = 0; b < 2; ++b) acc[a][b] = zero16();
  {
    const bf16_t* bp = B + (unsigned)((n0 + lr) * K + kc);
    gemm_main<false>(acc, A + (unsigned)((m0 + lr) * K + kc), (size_t)32 * K, bp, bp + (size_t)32 * K, bp + (size_t)64 * K, bp + (size_t)96 * K, K / 64, sA, sB, tid);
  }
  const int lane = tid & 63, w = tid >> 6, wm = w >> 1, wn = w & 1, r = lane & 31, hh = lane >> 5;
  const float* xin = (which == 0 && l == 0) ? p.in[s] : p.out + (size_t)s * TOK * 1024;
  float* xout = p.out + (size_t)s * TOK * 1024;
  const int cv = s == 0 ? 0 : 1 + (m0 >> 12);
  const float* modb = (const float*)(p.ws + OFF_MOD) + (size_t)(l * 3 + cv) * 6144 + (which == 0 ? 2048 : 5120);
  float* Fs = (float*)smem;
#pragma unroll
  for (int mi = 0; mi < 2; ++mi)
#pragma unroll
    for (int ni = 0; ni < 2; ++ni)
#pragma unroll
      for (int i = 0; i < 16; ++i)
        Fs[(wm * 64 + mi * 32 + crow(i, hh)) * 132 + wn * 64 + ni * 32 + r] = acc[mi][ni][i];
  __syncthreads();
  {
    const int frow = tid >> 5, fc4 = (tid & 31) * 4;
    const float4 gt = *(const float4*)(modb + n0 + fc4);
#pragma unroll
    for (int i = 0; i < 16; ++i) {
      const unsigned idx = (unsigned)((m0 + frow + 8 * i) * 1024 + n0 + fc4);
      const float4 a4 = *(const float4*)(Fs + (frow + 8 * i) * 132 + fc4);
      const float4 x4 = *(const float4*)(xin + idx);
      float4 o4; o4.x = x4.x + gt.x * a4.x; o4.y = x4.y + gt.y * a4.y; o4.z = x4.z + gt.z * a4.z; o4.w = x4.w + gt.w * a4.w;
      *(float4*)(xout + idx) = o4;
    }
  }
}

DI void ffnin_tile(const Params& p, int l, int t, char* smem, int tid) {
  const int nb = t % 44, mb = t / 44;
  const int m0 = mb * 128, j0 = nb * 64;
  bf16_t* sA = (bf16_t*)smem; bf16_t* sB = sA + 2 * GST;
  const bf16_t* A = (const bf16_t*)(p.ws + OFF_H);
  const bf16_t* B = (const bf16_t*)(p.ws + (size_t)l * WSET + OFF_WFI);
  const int lr = tid >> 3, kc = (tid & 7) * 8;
  f32x16 acc[2][2];
  for (int a = 0; a < 2; ++a) for (int b = 0; b < 2; ++b) acc[a][b] = zero16();
  {
    const bf16_t* bp = B + (unsigned)((j0 + lr) * 1024 + kc);
    gemm_main<false>(acc, A + (unsigned)((m0 + lr) * 1024 + kc), (size_t)32 * 1024, bp, bp + (size_t)DFF * 1024, bp + (size_t)32 * 1024, bp + (size_t)(DFF + 32) * 1024,
              16, sA, sB, tid);
  }
  const int lane = tid & 63, w = tid >> 6, wm = w >> 1, wn = w & 1, r = lane & 31, hh = lane >> 5;
  bf16_t* FF = (bf16_t*)(p.ws + OFF_FF);
  bf16_t* Gs = (bf16_t*)smem;
#pragma unroll
  for (int mi = 0; mi < 2; ++mi)
#pragma unroll
    for (int i = 0; i < 16; ++i)
      Gs[(wm * 64 + mi * 32 + crow(i, hh)) * 72 + 32 * wn + r] = f2bf(silu(acc[mi][0][i]) * acc[mi][1][i]);
  __syncthreads();
  {
    const int grow = tid >> 3, gc8 = (tid & 7) * 8;
#pragma unroll
    for (int i = 0; i < 4; ++i)
      *(u32x4*)(FF + (unsigned)((m0 + grow + 32 * i) * DFF + j0 + gc8)) = *(const u32x4*)(Gs + (grow + 32 * i) * 72 + gc8);
  }
}

DI void conv_item(const Params& p, int s, int l, int it, char* smem, int tid) {
  const int ntok = s == 0 ? 256 : 4096;
  const int tile0 = it * 16;
  const int seq0 = tile0 & ~(ntok - 1);
  const int n0 = tile0 - seq0;
  const bf16_t* SA = (const bf16_t*)(p.ws + OFF_SEGA);
  const float* cw = p.in[12] + (size_t)l * 31 * 512;
  bf16_t* As = (bf16_t*)smem;
  float* Cs = (float*)smem;
  __syncthreads();
#pragma unroll 4
  for (int id = tid; id < 46 * 64; id += 256) {
    const int rr = id >> 6, c8 = (id & 63) * 8;
    const int n = n0 - 15 + rr;
    u32x4 o = {0u, 0u, 0u, 0u};
    if (n >= 0 && n < ntok) {
      const bf16_t* rp = SA + (size_t)(seq0 + n) * 1024 + c8;
      const u32x4 vv = *(const u32x4*)rp, gg = *(const u32x4*)(rp + 512);
#pragma unroll
      for (int j = 0; j < 4; ++j) o[j] = pk2(bflo(vv[j]) * sigm(bflo(gg[j])), bfhi(vv[j]) * sigm(bfhi(gg[j])));
    }
    *(u32x4*)(As + rr * 520 + c8) = o;
  }
  __syncthreads();
  float acc0[16], acc1[16];
  {
    float w0[31], w1[31];
#pragma unroll
    for (int j = 0; j < 31; ++j) { float2 t2 = *(const float2*)(cw + j * 512 + 2 * tid); w0[j] = t2.x; w1[j] = t2.y; }
    const float2 cb = *(const float2*)(p.in[13] + l * 512 + 2 * tid);
#pragma unroll
    for (int t = 0; t < 16; ++t) { acc0[t] = cb.x; acc1[t] = cb.y; }
#pragma unroll
    for (int rr = 0; rr < 46; ++rr) {
      const unsigned av = *(const unsigned*)(As + rr * 520 + 2 * tid);
      const float a0 = bflo(av), a1 = bfhi(av);
#pragma unroll
      for (int t = 0; t < 16; ++t) {
        const int j = rr - t;
        if (j >= 0 && j <= 30) { acc0[t] += a0 * w0[j]; acc1[t] += a1 * w1[j]; }
      }
    }
  }
  __syncthreads();
#pragma unroll
  for (int t = 0; t < 16; ++t) { float2 o; o.x = acc0[t]; o.y = acc1[t]; *(float2*)(Cs + t * 516 + 2 * tid) = o; }
  __syncthreads();
  const int lane = tid & 63, w = tid >> 6;
  const float* lg = p.in[14] + l * 512 + lane * 8;
  const float* lb = p.in[15] + l * 512 + lane * 8;
  bf16_t* AA = (bf16_t*)(p.ws + OFF_ACTA);
#pragma unroll
  for (int tt = 0; tt < 4; ++tt) {
    const int t = w * 4 + tt;
    float x[8];
    float4 xa = *(const float4*)(Cs + t * 516 + lane * 8), xb = *(const float4*)(Cs + t * 516 + lane * 8 + 4);
    x[0] = xa.x; x[1] = xa.y; x[2] = xa.z; x[3] = xa.w; x[4] = xb.x; x[5] = xb.y; x[6] = xb.z; x[7] = xb.w;
    float sm = 0.f;
    for (int j = 0; j < 8; ++j) sm += x[j];
    for (int o = 32; o > 0; o >>= 1) sm += __shfl_xor(sm, o);
    const float mu = sm * (1.f / 512.f);
    float vs = 0.f;
    for (int j = 0; j < 8; ++j) { x[j] -= mu; vs += x[j] * x[j]; }
    for (int o = 32; o > 0; o >>= 1) vs += __shfl_xor(vs, o);
    const float rn = rsqrtf(vs * (1.f / 512.f) + 1e-5f);
    float y[8];
    for (int j = 0; j < 8; ++j) y[j] = silu(x[j] * rn * lg[j] + lb[j]);
    *(bf16x8*)(AA + (size_t)(tile0 + t) * 512 + lane * 8) = pack8(y[0], y[1], y[2], y[3], y[4], y[5], y[6], y[7]);
  }
}

DI void qkprep_item(const Params& p, int s, int l, int it, char* smem, int tid) {
  const int lane = tid & 63, w = tid >> 6;
  const bool ctx = it >= 128;
  const int ntok = s == 0 ? 256 : 4096;
  const int M = s == 0 ? 256 : 4352;
  const int coff = s == 0 ? 0 : 256;
  int b, npos0, tok0;
  if (!ctx) { tok0 = it * 64; b = tok0 / ntok; npos0 = coff + (tok0 - b * ntok); }
  else { b = (it - 128) >> 2; tok0 = 0; npos0 = ((it - 128) & 3) * 64; }
  const bf16_t* SC = (const bf16_t*)(p.ws + OFF_SEGC);
  bf16_t* QN = (bf16_t*)(p.ws + OFF_QN);
  bf16_t* KB = (bf16_t*)(p.ws + OFF_KB);
  bf16_t* VT = (bf16_t*)(p.ws + OFF_VT);
  const float* rope = (const float*)(p.ws + OFF_ROPE);
  const int g = lane >> 3, sub = lane & 7;
#pragma unroll 4
  for (int task = w; task < 128; task += 4) {
    const int which = task >> 6, tl = task & 63;
    if (ctx && which == 0) continue;
    float x[8];
    if (!ctx) {
      uint4 raw = *(const uint4*)(SC + (size_t)(tok0 + tl) * 1536 + which * 512 + g * 64 + sub * 8);
      x[0] = bflo(raw.x); x[1] = bfhi(raw.x); x[2] = bflo(raw.y); x[3] = bfhi(raw.y);
      x[4] = bflo(raw.z); x[5] = bfhi(raw.z); x[6] = bflo(raw.w); x[7] = bfhi(raw.w);
      float ss = 0.f;
      for (int j = 0; j < 8; ++j) ss += x[j] * x[j];
      ss += __shfl_xor(ss, 1); ss += __shfl_xor(ss, 2); ss += __shfl_xor(ss, 4);
      const float rn = rsqrtf(ss * (1.f / 64.f) + 1e-6f);
      const float* nw = p.in[which == 0 ? 18 : 19] + l * 64 + sub * 8;
      for (int j = 0; j < 8; ++j) x[j] = x[j] * rn * nw[j];
      if (s == 1) {
        const int pos = (tok0 + tl) & 4095;
        float4 cc = *(const float4*)(rope + pos * 32 + sub * 4), sn = *(const float4*)(rope + 131072 + pos * 32 + sub * 4);
        float c4[4] = {cc.x, cc.y, cc.z, cc.w}, s4[4] = {sn.x, sn.y, sn.z, sn.w};
        for (int q = 0; q < 4; ++q) {
          float x1 = x[2 * q], x2 = x[2 * q + 1];
          x[2 * q] = x1 * c4[q] - x2 * s4[q]; x[2 * q + 1] = x1 * s4[q] + x2 * c4[q];
        }
      }
    } else {
      const float* ck = p.in[2] + ((size_t)(b * 2 + l) * 256 + npos0 + tl) * 512 + g * 64 + sub * 8;
      float4 xa = *(const float4*)ck, xb = *(const float4*)(ck + 4);
      x[0] = xa.x; x[1] = xa.y; x[2] = xa.z; x[3] = xa.w; x[4] = xb.x; x[5] = xb.y; x[6] = xb.z; x[7] = xb.w;
    }
    if (which == 0) {
      *(bf16x8*)(QN + (size_t)(tok0 + tl) * 512 + g * 64 + sub * 8) =
          pack8(x[0] * QSCALE, x[1] * QSCALE, x[2] * QSCALE, x[3] * QSCALE, x[4] * QSCALE, x[5] * QSCALE, x[6] * QSCALE, x[7] * QSCALE);
    } else {
      *(bf16x8*)(KB + ((size_t)(b * 8 + g) * M + npos0 + tl) * 64 + sub * 8) = pack8(x[0], x[1], x[2], x[3], x[4], x[5], x[6], x[7]);
      if (s == 0) {
        float* ok = p.out + OUT_CK + ((size_t)(b * 2 + l) * 256 + (npos0 + tl)) * 512 + g * 64 + sub * 8;
        float4 oa = {x[0], x[1], x[2], x[3]}, ob = {x[4], x[5], x[6], x[7]};
        *(float4*)ok = oa; *(float4*)(ok + 4) = ob;
      }
    }
  }
  bf16_t* Vs = (bf16_t*)smem;
  for (int hd = 0; hd < 4; ++hd) {
    __syncthreads();
#pragma unroll
    for (int i = 0; i < 4; ++i) {
      const int id = tid + 256 * i;
      const int tl = id >> 4, ch = id & 15;
      uint4 raw;
      if (!ctx) {
        raw = *(const uint4*)(SC + (size_t)(tok0 + tl) * 1536 + 1024 + hd * 128 + ch * 8);
        if (s == 0) {
          float* ov = p.out + OUT_CV + ((size_t)(b * 2 + l) * 256 + (npos0 + tl)) * 512 + hd * 128 + ch * 8;
          float4 oa = {bflo(raw.x), bfhi(raw.x), bflo(raw.y), bfhi(raw.y)}, ob = {bflo(raw.z), bfhi(raw.z), bflo(raw.w), bfhi(raw.w)};
          *(float4*)ov = oa; *(float4*)(ov + 4) = ob;
        }
      } else {
        const float* cvp = p.in[3] + ((size_t)(b * 2 + l) * 256 + npos0 + tl) * 512 + hd * 128 + ch * 8;
        float4 xa = *(const float4*)cvp, xb = *(const float4*)(cvp + 4);
        raw.x = pk2(xa.x, xa.y); raw.y = pk2(xa.z, xa.w); raw.z = pk2(xb.x, xb.y); raw.w = pk2(xb.z, xb.w);
      }
      *(uint4*)(Vs + tl * 136 + ch * 8) = raw;
    }
    __syncthreads();
    const int e = tid & 127, half = tid >> 7;
    bf16_t* dstp = VT + ((size_t)(b * 4 + hd) * 128 + e) * M + npos0 + 32 * half;
#pragma unroll
    for (int q = 0; q < 4; ++q) {
      unsigned u[4];
#pragma unroll
      for (int j = 0; j < 4; ++j) {
        unsigned lo = Vs[(32 * half + 8 * q + 2 * j) * 136 + e], hi = Vs[(32 * half + 8 * q + 2 * j + 1) * 136 + e];
        u[j] = lo | (hi << 16);
      }
      uint4 o; o.x = u[0]; o.y = u[1]; o.z = u[2]; o.w = u[3];
      *(uint4*)(dstp + 8 * q) = o;
    }
  }
}

DI void attn_item(const Params& p, int s, int l, int it, char* smem, int tid) {
  const int lane = tid & 63, w = tid >> 6, r = lane & 31, hh = lane >> 5;
  const int c = w >> 1, qsub = w & 1;
  const int ntok = s == 0 ? 256 : 4096;
  const int M = s == 0 ? 256 : 4352;
  const int qbs = ntok >> 6;
  const int qb = it % qbs, bh = it / qbs;
  const int b = bh >> 2, h = bh & 3;
  const int tq = b * ntok + qb * 64 + qsub * 32 + r;
  const bf16_t* QN = (const bf16_t*)(p.ws + OFF_QN);
  const bf16_t* Kg = (const bf16_t*)(p.ws + OFF_KB) + (size_t)bh * 2 * M * 64;
  const bf16_t* Vg = (const bf16_t*)(p.ws + OFF_VT) + (size_t)bh * 128 * M;
  bf16_t* Ks = (bf16_t*)smem;
  bf16x8 bq[4];
#pragma unroll
  for (int ks = 0; ks < 4; ++ks) bq[ks] = *(const bf16x8*)(QN + (size_t)tq * 512 + h * 128 + c * 64 + ks * 16 + hh * 8);
  f32x16 O[4];
  for (int e = 0; e < 4; ++e) O[e] = zero16();
  float mrun = -INFINITY, lrun = 0.f;
  const int nt = M >> 6;
  uint4 rk0, rk1, rk2, rk3, rv0, rv1, rv2, rv3;
  const int ch8 = (tid & 7) * 8;
  const bf16_t* kp0 = Kg + (size_t)((tid >> 3) & 63) * 64 + ch8;
  const bf16_t* kp1 = kp0 + (size_t)M * 64;
  const bf16_t* vp = Vg + (size_t)(tid >> 3) * M + ch8;
#define GLOAD(KT) { \
    rk0 = *(const uint4*)(kp0 + (size_t)(KT) * 4096); rk1 = *(const uint4*)(kp0 + (size_t)(KT) * 4096 + 2048); \
    rk2 = *(const uint4*)(kp1 + (size_t)(KT) * 4096); rk3 = *(const uint4*)(kp1 + (size_t)(KT) * 4096 + 2048); \
    rv0 = *(const uint4*)(vp + (KT) * 64); rv1 = *(const uint4*)(vp + (size_t)32 * M + (KT) * 64); \
    rv2 = *(const uint4*)(vp + (size_t)64 * M + (KT) * 64); rv3 = *(const uint4*)(vp + (size_t)96 * M + (KT) * 64); }
#define VSTORE(E, RV) { uint2 lo_, hi_; lo_.x = RV.x; lo_.y = RV.y; hi_.x = RV.z; hi_.y = RV.w; \
    *(uint2*)(Vs + (E) * 68 + ch8) = lo_; *(uint2*)(Vs + (E) * 68 + ch8 + 4) = hi_; }
  constexpr int AST = 2 * 64 * 72 + 128 * 68;
#define ASTORE(ST) { bf16_t* Kw = Ks + (ST) * AST; bf16_t* Vs = Kw + 2 * 64 * 72; const int key = (tid >> 3) & 63, e = tid >> 3; \
      *(uint4*)(Kw + (key) * 72 + ch8) = rk0; *(uint4*)(Kw + (32 + key) * 72 + ch8) = rk1; \
      *(uint4*)(Kw + (64 + key) * 72 + ch8) = rk2; *(uint4*)(Kw + (96 + key) * 72 + ch8) = rk3; \
      VSTORE(e, rv0); VSTORE(e + 32, rv1); VSTORE(e + 64, rv2); VSTORE(e + 96, rv3); }
  GLOAD(0);
  __syncthreads();
  ASTORE(0);
  if (nt > 1) GLOAD(1);
  __syncthreads();
  for (int kt = 0; kt < nt; ++kt) {
    const bf16_t* Kc = Ks + (kt & 1) * AST;
    const bf16_t* Vc = Kc + 2 * 64 * 72;
    f32x16 S[2];
    const float negm = kt == 0 ? 0.f : -mrun;
    __builtin_amdgcn_s_setprio(1);
#pragma unroll
    for (int kk = 0; kk < 2; ++kk) {
#pragma unroll
      for (int i = 0; i < 16; ++i) S[kk][i] = negm;
#pragma unroll
      for (int ks = 0; ks < 4; ++ks) {
        bf16x8 ka = *(const bf16x8*)(Kc + (c * 64 + kk * 32 + r) * 72 + ks * 16 + hh * 8);
        S[kk] = MFMA(ka, bq[ks], S[kk]);
      }
    }
    __builtin_amdgcn_s_setprio(0);
    float mx = S[0][0];
#pragma unroll
    for (int i = 0; i < 16; ++i) { mx = fmaxf(mx, S[0][i]); mx = fmaxf(mx, S[1][i]); }
    mx = fmaxf(mx, __shfl_xor(mx, 32));
    if (__builtin_amdgcn_ballot_w64(kt == 0 || mx > 8.f) != 0ull) {
      const float dm = fmaxf(mx, 0.f);
      const float mold = kt == 0 ? 0.f : mrun;
      const float mnew = kt == 0 ? mx : mold + dm;
      const float shift = mnew - mold;
      const float alpha = kt == 0 ? 0.f : __builtin_amdgcn_exp2f(-shift);
      mrun = mnew;
      lrun *= alpha;
#pragma unroll
      for (int e = 0; e < 4; ++e)
#pragma unroll
        for (int i = 0; i < 16; ++i) O[e][i] *= alpha;
#pragma unroll
      for (int i = 0; i < 16; ++i) { S[0][i] -= shift; S[1][i] -= shift; }
    }
    f32x2 ps2 = {0.f, 0.f};
#pragma unroll
    for (int i = 0; i < 16; ++i) {
      S[0][i] = __builtin_amdgcn_exp2f(S[0][i]); S[1][i] = __builtin_amdgcn_exp2f(S[1][i]);
      f32x2 t2 = {S[0][i], S[1][i]};
      ps2 += t2;
    }
    lrun += ps2[0] + ps2[1];
    bf16x8 pb[2][2];
    pb[0][0] = PACK_STEP(S[0], 0); pb[0][1] = PACK_STEP(S[0], 1); pb[1][0] = PACK_STEP(S[1], 0); pb[1][1] = PACK_STEP(S[1], 1);
    __builtin_amdgcn_s_setprio(1);
#pragma unroll
    for (int e = 0; e < 4; ++e)
#pragma unroll
      for (int kk = 0; kk < 2; ++kk)
#pragma unroll
        for (int s2 = 0; s2 < 2; ++s2) {
          bf16x8 va = ld_perm(Vc + (e * 32 + r) * 68 + kk * 32 + 16 * s2 + 4 * hh);
          O[e] = MFMA(va, pb[kk][s2], O[e]);
        }
    __builtin_amdgcn_s_setprio(0);
    __builtin_amdgcn_sched_barrier(0);
    if (kt + 1 < nt) {
      ASTORE((kt + 1) & 1);
      if (kt + 2 < nt) GLOAD(kt + 2);
    }
    __syncthreads();
  }
  const float ltot = lrun + __shfl_xor(lrun, 32);
  const float inv = 1.f / ltot;
  float* Xs = (float*)smem;
  __syncthreads();
  if (c == 1) {
#pragma unroll
    for (int e = 0; e < 4; ++e)
#pragma unroll
      for (int i = 0; i < 16; ++i) Xs[(qsub * 64 + e * 16 + i) * 64 + lane] = O[e][i] * inv;
  }
  __syncthreads();
  if (c == 0) {
    const float lam = ((const float*)(p.ws + OFF_MISC))[l];
    float ss = 0.f;
#pragma unroll
    for (int e = 0; e < 4; ++e)
#pragma unroll
      for (int i = 0; i < 16; ++i) {
        float v = O[e][i] * inv - lam * Xs[(qsub * 64 + e * 16 + i) * 64 + lane];
        O[e][i] = v; ss += v * v;
      }
    ss += __shfl_xor(ss, 32);
    const float rn = rsqrtf(ss * (1.f / 128.f) + 1e-6f) * ((const float*)(p.ws + OFF_MISC))[2 + l];
    const float* sl = p.in[21] + l * 128;
    bf16_t* OC = (bf16_t*)(p.ws + OFF_OC) + (size_t)tq * 512 + h * 128;
#pragma unroll
    for (int e = 0; e < 4; ++e)
#pragma unroll
      for (int g4 = 0; g4 < 4; ++g4) {
        const int e0 = e * 32 + 8 * g4 + 4 * hh;
        float4 sw = *(const float4*)(sl + e0);
        uint2 o;
        o.x = pk2(O[e][4 * g4 + 0] * rn * sw.x, O[e][4 * g4 + 1] * rn * sw.y);
        o.y = pk2(O[e][4 * g4 + 2] * rn * sw.z, O[e][4 * g4 + 3] * rn * sw.w);
        *(uint2*)(OC + e0) = o;
      }
  }
}

struct HgrnSmem {
  bf16_t Qs[32 * 136]; bf16_t Ks[32 * 136]; bf16_t KTs[128 * 40]; bf16_t VTs[128 * 40];
  float ebs[128]; float tot[2][128];
  bf16_t raw[3 * 4096];
};
struct HgrnPref { u32x4 z0, z1, q0, q1, v0, v1; };

template <int OUT>
DI void hgrn_prefetch(HgrnPref& pf, const bf16_t* SH, int tk0, int h, int dir, int tid) {
  const bf16_t* g = SH + (size_t)(tk0 + (tid >> 4)) * 2560 + h * 128 + (tid & 15) * 8;
  pf.z0 = *(const u32x4*)(g + 1024 + dir * 512); pf.z1 = *(const u32x4*)(g + 16 * 2560 + 1024 + dir * 512);
  pf.v0 = *(const u32x4*)(g + 512);              pf.v1 = *(const u32x4*)(g + 16 * 2560 + 512);
  if (OUT != 0) { pf.q0 = *(const u32x4*)(g);    pf.q1 = *(const u32x4*)(g + 16 * 2560); }
}

template <int OUT>
DI float hgrn_chunk(const Params& p, HgrnSmem& sm, int s, int l, int tk0, int tkn, int h, int dir, float lbv, f32x16 (&S)[4], HgrnPref& pf, int tid_in) {
  int tid = tid_in;
  asm volatile("" : "+v"(tid));
  int lane = tid & 63, w = tid >> 6, r = lane & 31, hh = lane >> 5;
  int d = tid & 127, half = tid >> 7;
#define REDERIVE { asm volatile("" : "+v"(tid)); lane = tid & 63; w = tid >> 6; r = lane & 31; hh = lane >> 5; d = tid & 127; half = tid >> 7; }
  const bf16_t* SH = (const bf16_t*)(p.ws + OFF_SEGH);
  {
    const int ro = (tid >> 4) * 128 + (tid & 15) * 8;
    *(u32x4*)(sm.raw + ro) = pf.z0; *(u32x4*)(sm.raw + ro + 16 * 128) = pf.z1;
    *(u32x4*)(sm.raw + 8192 + ro) = pf.v0; *(u32x4*)(sm.raw + 8192 + ro + 16 * 128) = pf.v1;
    if (OUT != 0) { *(u32x4*)(sm.raw + 4096 + ro) = pf.q0; *(u32x4*)(sm.raw + 4096 + ro + 16 * 128) = pf.q1; }
  }
  if (tkn >= 0) hgrn_prefetch<OUT>(pf, SH, tkn, h, dir, tid);
  __syncthreads();
  float lf[16], kg[16];
#pragma unroll
  for (int i = 0; i < 16; ++i) {
    const float z = bf2f(sm.raw[(16 * half + i) * 128 + d]);
    const float e = __expf(-z);
    const float sg = __builtin_amdgcn_rcpf(1.f + e);
    const float f = lbv + (1.f - lbv) * sg;
    kg[i] = (1.f - lbv) * e * sg;
    lf[i] = __logf(f);
  }
  float run = 0.f;
  if (dir == 0) {
#pragma unroll
    for (int i = 0; i < 16; ++i) { run += lf[i]; lf[i] = run; }
  } else {
#pragma unroll
    for (int i = 15; i >= 0; --i) { run += lf[i]; lf[i] = run; }
  }
  sm.tot[half][d] = run;
  __syncthreads();
  REDERIVE
  const float t0 = sm.tot[0][d], t1 = sm.tot[1][d];
  const float off = dir == 0 ? (half ? t0 : 0.f) : (half ? 0.f : t1);
  if (half == 0) sm.ebs[d] = __expf(t0 + t1);
#pragma unroll
  for (int g8 = 0; g8 < 2; ++g8) {
    float kt[8], vv[8];
#pragma unroll
    for (int i = 0; i < 8; ++i) {
      const int tl = 16 * half + 8 * g8 + i;
      vv[i] = bf2f(sm.raw[8192 + tl * 128 + d]);
      const float bb = lf[8 * g8 + i] + off;
      kt[i] = kg[8 * g8 + i] * __expf(-bb);
      sm.Ks[tl * 136 + d] = f2bf(kt[i]);
      if (OUT != 0) {
        const float qv = bf2f(sm.raw[4096 + tl * 128 + d]);
        sm.Qs[tl * 136 + d] = f2bf(silu(qv) * __expf(bb));
      }
    }
    *(bf16x8*)(sm.KTs + d * 40 + 16 * half + 8 * g8) = pack8(kt[0], kt[1], kt[2], kt[3], kt[4], kt[5], kt[6], kt[7]);
    *(bf16x8*)(sm.VTs + d * 40 + 16 * half + 8 * g8) = pack8(vv[0], vv[1], vv[2], vv[3], vv[4], vv[5], vv[6], vv[7]);
  }
  __syncthreads();
  REDERIVE
  if (OUT != 0) {
    float* OSC = (float*)(p.ws + osc_off(s));
    __builtin_amdgcn_s_setprio(1);
    f32x16 at = zero16(), at1 = zero16();
#pragma unroll
    for (int ks = 0; ks < 8; ks += 2) {
      bf16x8 ka = *(const bf16x8*)(sm.Ks + r * 136 + ks * 16 + hh * 8);
      bf16x8 qb = *(const bf16x8*)(sm.Qs + r * 136 + ks * 16 + hh * 8);
      at = MFMA(ka, qb, at);
      bf16x8 ka1 = *(const bf16x8*)(sm.Ks + r * 136 + ks * 16 + 16 + hh * 8);
      bf16x8 qb1 = *(const bf16x8*)(sm.Qs + r * 136 + ks * 16 + 16 + hh * 8);
      at1 = MFMA(ka1, qb1, at1);
    }
#pragma unroll
    for (int i = 0; i < 16; ++i) {
      const int srow = crow(i, hh);
      const bool keep = dir == 0 ? (srow <= r) : (srow >= r);
      at[i] = keep ? at[i] + at1[i] : 0.f;
    }
    __builtin_amdgcn_sched_barrier(0);
    f32x16 o = zero16();
#pragma unroll
    for (int s2 = 0; s2 < 2; ++s2) {
      bf16x8 pa = s2 == 0 ? PACK_STEP(at, 0) : PACK_STEP(at, 1);
      bf16x8 vf = ld_perm(sm.VTs + (32 * w + r) * 40 + 16 * s2 + 4 * hh);
      o = MFMA(pa, vf, o);
    }
    __builtin_amdgcn_sched_barrier(0);
    f32x16 o1 = zero16();
#pragma unroll
    for (int dt = 0; dt < 4; ++dt) {
      {
        bf16x8 qa = ld_perm(sm.Qs + r * 136 + 32 * dt + 4 * hh);
        bf16x8 sb = PACK_STEP(S[dt], 0);
        o = MFMA(qa, sb, o);
      }
      {
        bf16x8 qa = ld_perm(sm.Qs + r * 136 + 32 * dt + 16 + 4 * hh);
        bf16x8 sb = PACK_STEP(S[dt], 1);
        o1 = MFMA(qa, sb, o1);
      }
    }
#pragma unroll
    for (int i = 0; i < 16; ++i) o[i] += o1[i];
    __builtin_amdgcn_sched_barrier(0);
    if (OUT == 1) {
#pragma unroll
      for (int i = 0; i < 16; ++i) OSC[(size_t)(tk0 + crow(i, hh)) * 512 + h * 128 + 32 * w + r] = o[i];
    } else {
      bf16_t* OSB = (bf16_t*)(p.ws + osb_off(s));
#pragma unroll
      for (int i = 0; i < 16; ++i) OSB[(size_t)(tk0 + crow(i, hh)) * 512 + h * 128 + 32 * w + r] = f2bf(o[i]);
    }
  }
  __builtin_amdgcn_sched_barrier(0);
  __builtin_amdgcn_s_setprio(1);
  REDERIVE
#pragma unroll
  for (int dt = 0; dt < 4; ++dt) {
#pragma unroll
    for (int ks = 0; ks < 2; ++ks) {
      bf16x8 ka = *(const bf16x8*)(sm.KTs + (32 * dt + r) * 40 + 16 * ks + 8 * hh);
      bf16x8 vb = *(const bf16x8*)(sm.VTs + (32 * w + r) * 40 + 16 * ks + 8 * hh);
      S[dt] = MFMA(ka, vb, S[dt]);
    }
#pragma unroll
    for (int g4 = 0; g4 < 4; ++g4) {
      float4 e4 = *(const float4*)(sm.ebs + 32 * dt + 8 * g4 + 4 * hh);
      S[dt][4 * g4 + 0] *= e4.x; S[dt][4 * g4 + 1] *= e4.y; S[dt][4 * g4 + 2] *= e4.z; S[dt][4 * g4 + 3] *= e4.w;
    }
  }
  __builtin_amdgcn_s_setprio(0);
  return t0 + t1;
}

DI void state_load(f32x16 (&S)[4], const float* base, int w, int r, int hh) {
  const float* q = base + (4 * hh) * 128 + 32 * w + r;
#pragma unroll
  for (int dt = 0; dt < 4; ++dt)
#pragma unroll
    for (int g4 = 0; g4 < 4; ++g4) {
#pragma unroll
      for (int j = 0; j < 4; ++j) S[dt][4 * g4 + j] = q[j * 128];
      q += 1024;
      asm volatile("" : "+v"(q));
    }
}
DI void state_store(const f32x16 (&S)[4], float* base, int w, int r, int hh) {
  float* q = base + (4 * hh) * 128 + 32 * w + r;
#pragma unroll
  for (int dt = 0; dt < 4; ++dt)
#pragma unroll
    for (int g4 = 0; g4 < 4; ++g4) {
#pragma unroll
      for (int j = 0; j < 4; ++j) q[j * 128] = S[dt][4 * g4 + j];
      q += 1024;
      asm volatile("" : "+v"(q));
    }
}
DI void state_scan(f32x16 (&S)[4], const float* base, const float* ebs, int w, int r, int hh) {
  const float* q = base + (4 * hh) * 128 + 32 * w + r;
#pragma unroll
  for (int dt = 0; dt < 4; ++dt) {
    __builtin_amdgcn_sched_barrier(0);
#pragma unroll
    for (int g4 = 0; g4 < 4; ++g4) {
      float4 e4 = *(const float4*)(ebs + 32 * dt + 8 * g4 + 4 * hh);
      S[dt][4 * g4 + 0] = e4.x * S[dt][4 * g4 + 0] + q[0];
      S[dt][4 * g4 + 1] = e4.y * S[dt][4 * g4 + 1] + q[128];
      S[dt][4 * g4 + 2] = e4.z * S[dt][4 * g4 + 2] + q[256];
      S[dt][4 * g4 + 3] = e4.w * S[dt][4 * g4 + 3] + q[384];
      q += 1024;
      asm volatile("" : "+v"(q));
    }
  }
}

DI float hgrn_lb(const Params& p, int l, int dir, int ch) {
  if (l == 0) return 0.f;
  const float* lb = p.in[16];
  float a = lb[(0 * 2 + dir) * 512 + ch], b = lb[(1 * 2 + dir) * 512 + ch];
  return 1.f / (1.f + __expf(a - b));
}

DI void hgrn_pass1_item(const Params& p, int l, int it, char* smem, int tid) {
  HgrnSmem& sm = *(HgrnSmem*)smem;
  const int j = it & 15, dir = (it >> 4) & 1, h = (it >> 5) & 3, b = it >> 7;
  const int lane = tid & 63, w = tid >> 6, r = lane & 31, hh = lane >> 5;
  const int d = tid & 127;
  const bf16_t* SH = (const bf16_t*)(p.ws + OFF_SEGH);
  const float lbv = hgrn_lb(p, l, dir, h * 128 + d);
  f32x16 S[4];
  for (int i = 0; i < 4; ++i) S[i] = zero16();
  float bt = 0.f;
  const int base = b * 4096 + j * 256;
  HgrnPref pf = {};
  hgrn_prefetch<0>(pf, SH, base + (dir == 0 ? 0 : 7) * 32, h, dir, tid);
  __syncthreads();
#pragma unroll 1
  for (int cc = 0; cc < 8; ++cc) {
    const int c = dir == 0 ? cc : 7 - cc;
    const int cn = dir == 0 ? c + 1 : c - 1;
    bt += hgrn_chunk<0>(p, sm, 1, l, base + c * 32, cc < 7 ? base + cn * 32 : -1, h, dir, lbv, S, pf, tid);
  }
  state_store(S, (float*)(p.ws + OFF_SLOC) + (size_t)it * 16384, w, r, hh);
  if (tid < 128) ((float*)(p.ws + OFF_BTOT))[(size_t)it * 128 + d] = bt;
}

DI void hgrn_pass2_item(const Params& p, int s, int l, int it, char* smem, int tid_in) {
  HgrnSmem& sm = *(HgrnSmem*)smem;
  int tid = tid_in;
  asm volatile("" : "+v"(tid));
  const int nj = s == 0 ? 1 : 16;
  const int ntok = s == 0 ? 256 : 4096;
  const int dir = it & 1, it2 = it >> 1;
  const int j = it2 % nj, bh = it2 / nj, h = bh & 3, b = bh >> 2;
  int lane = tid & 63, w = tid >> 6, r = lane & 31, hh = lane >> 5;
  int d = tid & 127;
#define REDERIVE2 { asm volatile("" : "+v"(tid)); lane = tid & 63; w = tid >> 6; r = lane & 31; hh = lane >> 5; d = tid & 127; }
  const bf16_t* SH = (const bf16_t*)(p.ws + OFF_SEGH);
  const float* SLb = (const float*)(p.ws + OFF_SLOC);
  const float* BTb = (const float*)(p.ws + OFF_BTOT);
  const int base = b * ntok + j * 256;
  const float lbv = hgrn_lb(p, l, dir, h * 128 + d);
  HgrnPref pf = {};
  if (dir == 0) hgrn_prefetch<1>(pf, SH, base, h, 0, tid);
  else          hgrn_prefetch<2>(pf, SH, base + 7 * 32, h, 1, tid);
  f32x16 S[4];
  __syncthreads();
  if (s == 0) { for (int i = 0; i < 4; ++i) S[i] = zero16(); }
  else {
    state_load(S, p.in[4] + (size_t)(((b * 2 + l) * 2 + dir) * 4 + h) * 16384, w, r, hh);
    const int nsteps = dir == 0 ? j : 15 - j;
    float* ebt = (float*)sm.raw;
    for (int q = tid; q < nsteps * 128; q += 256) {
      const int st = q >> 7, dd = q & 127;
      const int jj = dir == 0 ? st : 15 - st;
      ebt[q] = __expf(BTb[(size_t)((bh * 2 + dir) * 16 + jj) * 128 + dd]);
    }
    __syncthreads();
#pragma unroll 1
    for (int st = 0; st < nsteps; ++st) {
      REDERIVE2
      const int jj = dir == 0 ? st : 15 - st;
      state_scan(S, SLb + (size_t)((bh * 2 + dir) * 16 + jj) * 16384, ebt + st * 128, w, r, hh);
    }
    __syncthreads();
  }
  if (dir == 0) {
#pragma unroll 1
    for (int c = 0; c < 8; ++c) hgrn_chunk<1>(p, sm, s, l, base + c * 32, c < 7 ? base + (c + 1) * 32 : -1, h, 0, lbv, S, pf, tid);
  } else {
#pragma unroll 1
    for (int c = 7; c >= 0; --c) hgrn_chunk<2>(p, sm, s, l, base + c * 32, c > 0 ? base + (c - 1) * 32 : -1, h, 1, lbv, S, pf, tid);
  }
  if (s == 0) {
    REDERIVE2
    state_store(S, p.out + OUT_ST + (size_t)(((b * 2 + l) * 2 + dir) * 4 + h) * 16384, w, r, hh);
  }
}

DI void hgrn_fin_item(const Params& p, int s, int l, int it, int tid) {
  const int grp = it * 32 + (tid >> 3), sub = tid & 7;
  const int tok = grp >> 2, h = grp & 3;
  const size_t o = (size_t)tok * 512 + h * 128 + 16 * sub;
  const float* of = (const float*)(p.ws + osc_off(s)) + o;
  const bf16_t* ob = (const bf16_t*)(p.ws + osb_off(s)) + o;
  const bf16_t* hgp = (const bf16_t*)(p.ws + OFF_SEGH) + (size_t)tok * 2560 + 2048 + h * 128 + 16 * sub;
  const float* gn = p.in[17] + l * 128 + 16 * sub;
  float x[16];
#pragma unroll
  for (int q = 0; q < 4; ++q) { float4 v = *(const float4*)(of + 4 * q); x[4 * q] = v.x; x[4 * q + 1] = v.y; x[4 * q + 2] = v.z; x[4 * q + 3] = v.w; }
  const u32x4 b0 = *(const u32x4*)ob, b1 = *(const u32x4*)(ob + 8);
  const u32x4 h0 = *(const u32x4*)hgp, h1 = *(const u32x4*)(hgp + 8);
#pragma unroll
  for (int q = 0; q < 4; ++q) { x[2 * q] += bflo(b0[q]); x[2 * q + 1] += bfhi(b0[q]); x[8 + 2 * q] += bflo(b1[q]); x[8 + 2 * q + 1] += bfhi(b1[q]); }
  float ss = 0.f;
#pragma unroll
  for (int j = 0; j < 16; ++j) ss += x[j] * x[j];
  ss += __shfl_xor(ss, 1); ss += __shfl_xor(ss, 2); ss += __shfl_xor(ss, 4);
  const float rn = rsqrtf(ss * (1.f / 128.f) + 1e-6f);
  float y[16];
#pragma unroll
  for (int q = 0; q < 4; ++q) {
    y[2 * q] = x[2 * q] * rn * gn[2 * q] * silu(bflo(h0[q]));             y[2 * q + 1] = x[2 * q + 1] * rn * gn[2 * q + 1] * silu(bfhi(h0[q]));
    y[8 + 2 * q] = x[8 + 2 * q] * rn * gn[8 + 2 * q] * silu(bflo(h1[q])); y[8 + 2 * q + 1] = x[8 + 2 * q + 1] * rn * gn[8 + 2 * q + 1] * silu(bfhi(h1[q]));
  }
  bf16_t* ab = (bf16_t*)(p.ws + OFF_ACTB) + o;
  *(bf16x8*)ab = pack8(y[0], y[1], y[2], y[3], y[4], y[5], y[6], y[7]);
  *(bf16x8*)(ab + 8) = pack8(y[8], y[9], y[10], y[11], y[12], y[13], y[14], y[15]);
}

#define XB_TMO      128
#define XB_XCNT(j)  (256  + 64 * (j))
#define XB_XSUB(j)  (1280 + 64 * (j))
#define XB_XGEN(j)  (2304 + 64 * (j))
#define XB_TOP      3328
#define XB_TOPGEN   3392
#define XCD_BAR_WORDS 3456
#define XB_SPIN_CAP (1u << 22)
#define LAS __attribute__((address_space(3)))
DI unsigned xb_ld(unsigned* p)              { return __hip_atomic_load(p, __ATOMIC_RELAXED, __HIP_MEMORY_SCOPE_AGENT); }
DI unsigned xb_add(unsigned* p, unsigned v) { return __hip_atomic_fetch_add(p, v, __ATOMIC_RELAXED, __HIP_MEMORY_SCOPE_AGENT); }
DI unsigned xb_xcc_id() { return (unsigned)__builtin_amdgcn_s_getreg((3 << 11) | 20) & 0xFu; }
#define XB_SPIN(cond, bar) do { unsigned _sp = 0; while (cond) { __builtin_amdgcn_s_sleep(1); \
    if ((++_sp & 255u) == 0u) { if (xb_ld(&(bar)[XB_TMO])) break; if (_sp > XB_SPIN_CAP) { atomicAdd(&(bar)[XB_TMO], 1u); break; } } } } while (0)
struct XcdBarrier { unsigned* bar; unsigned x; volatile LAS unsigned* st; };
DI XcdBarrier xcd_barrier_post(unsigned* bar, volatile LAS unsigned* st) {
  XcdBarrier b; b.bar = bar; b.x = xb_xcc_id(); b.st = st;
  if (threadIdx.x == 0) (void)xb_add(&bar[XB_XCNT(b.x)], 1u);
  return b;
}
DI void xcd_barrier_complete(unsigned* bar, unsigned x, unsigned& nloc, unsigned& nx) {
  const unsigned G = gridDim.x * gridDim.y * gridDim.z;
  unsigned sum, cnt, mine, sp = 0u;
  for (;;) {
    sum = 0u; cnt = 0u; mine = 0u;
#pragma unroll
    for (unsigned j = 0; j < 16; ++j) { const unsigned c = xb_ld(&bar[XB_XCNT(j)]); sum += c; cnt += (c > 0u) ? 1u : 0u; mine = (j == x) ? c : mine; }
    if (sum == G) break;
    __builtin_amdgcn_s_sleep(1);
    if ((++sp & 255u) == 0u) { if (xb_ld(&bar[XB_TMO])) break; if (sp > XB_SPIN_CAP) { atomicAdd(&bar[XB_TMO], 1u); break; } }
  }
  nloc = mine > 0u ? mine : 1u; nx = cnt > 0u ? cnt : 1u;
}
DI void xcd_barrier(const XcdBarrier& b) {
  asm volatile("s_waitcnt vmcnt(0)" ::: "memory");
  __syncthreads();
  if (threadIdx.x == 0) {
    unsigned* bar = b.bar;
    __builtin_amdgcn_s_waitcnt(0);
    unsigned nloc = b.st[0], nx = b.st[1];
    if (nloc == 0u) { xcd_barrier_complete(bar, b.x, nloc, nx); b.st[0] = nloc; b.st[1] = nx; }
    const unsigned old = xb_add(&bar[XB_XSUB(b.x)], 1u);
    const unsigned gen = old / nloc;
    if (old + 1u == (gen + 1u) * nloc) {
      __builtin_amdgcn_fence(__ATOMIC_RELEASE, "agent");
      asm volatile("s_waitcnt vmcnt(0)" ::: "memory");
      const unsigned og = xb_add(&bar[XB_TOP], 1u);
      const unsigned tg = og / nx;
      if (og + 1u == (tg + 1u) * nx) xb_add(&bar[XB_TOPGEN], 1u);
      else XB_SPIN(xb_ld(&bar[XB_TOPGEN]) == tg, bar);
      __builtin_amdgcn_fence(__ATOMIC_ACQUIRE, "agent");
      xb_add(&bar[XB_XGEN(b.x)], 1u);
      asm volatile("s_waitcnt vmcnt(0)" ::: "memory");
    } else {
      XB_SPIN(xb_ld(&bar[XB_XGEN(b.x)]) == gen, bar);
      __builtin_amdgcn_fence(__ATOMIC_ACQUIRE, "agent");
      asm volatile("s_waitcnt vmcnt(0)" ::: "memory");
    }
  }
  __syncthreads();
}

#define OPQ unsigned zz_ = 0u; asm volatile("" : "+v"(zz_)); int tid = wv64 + (int)__builtin_amdgcn_mbcnt_hi(~0u, __builtin_amdgcn_mbcnt_lo(~0u, zz_)); asm volatile("" : "+v"(tid))

constexpr int NPH = 41;
#ifndef REP
#define REP 0
#endif

__global__ void __launch_bounds__(256, 2) fwd_kernel(Params p, int ph_lo, int ph_hi) {
  __shared__ __attribute__((aligned(16))) char smem[SMEM_BYTES];
  __shared__ uint4 xb_words;
  const int nb = gridDim.x;
  const int wv64 = __builtin_amdgcn_readfirstlane((int)(threadIdx.x & ~63u));
  XcdBarrier xb;
  if (ph_hi - ph_lo > 1) {
    if (threadIdx.x == 0) xb_words = make_uint4(0u, 0u, 0u, 0u);
    __syncthreads();
    xb = xcd_barrier_post((unsigned*)(p.ws + OFF_BAR), (volatile LAS unsigned*)&xb_words);
  }
#if REP
  for (int pp = 2 * ph_lo; pp < 2 * ph_hi; ++pp) {
    const int ph = pp >> 1;
    if ((pp & 1) && (ph == 0 || !((REP >> ((ph - 1) % 10)) & 1))) continue;
#else
  for (int ph = ph_lo; ph < ph_hi; ++ph) {
#endif
    int bid = blockIdx.x;
    asm volatile("" : "+s"(bid));
    if (ph == 0) {
      for (int it = bid; it < 192 + 64 + 1; it += nb) {
        OPQ;
        if (it < 192) mod_item(p, it, smem, tid);
        else if (it < 256) rope_item(p, it - 192, tid);
        else misc_item(p, tid);
      }
    } else {
      const int q = ph - 1;
      const int l = q / 20, s = (q / 10) & 1, k = q % 10;
      if (k == 0 && q != 0) continue;
      switch (k) {
        case 0: {
          for (int it = bid; it < 512 + 1024; it += nb) {
        OPQ;
            if (it < 512) norm_item(p, s, l, 0, it, tid);
            else convert_tile(p, 0, it - 512, smem, tid);
          }
        } break;
        case 1: for (int it = bid; it < 4096; it += nb) { OPQ; gemm1_tile(p, l, it, smem, tid); } break;
        case 2: {
          const int n1 = s == 1 ? 256 : 0;
          const int nq = s == 1 ? 136 : 128;
          const int ncv = (l == 0 && s == 0) ? 1376 : 0;
          if (s == 0) {
            const int ntot = 256 + 512 + nq + ncv;
            unsigned* ctr = (unsigned*)(p.ws + OFF_BAR) + 3600 + 4 * q + 2;
            for (;;) {
              __syncthreads();
              if (threadIdx.x == 0) xb_words.z = atomicAdd(ctr, 1u);
              __syncthreads();
              const int it = (int)xb_words.z;
              if (it >= ntot) break;
        OPQ;
              if (it < 256) hgrn_pass2_item(p, s, l, it, smem, tid);
              else if (it < 256 + nq) qkprep_item(p, s, l, it - 256, smem, tid);
              else if (it < 768 + nq) conv_item(p, s, l, it - 256 - nq, smem, tid);
              else convert_tile(p, 0, 1024 + it - (768 + nq), smem, tid);
            }
          } else
          for (int it = bid; it < n1 + 512 + nq + ncv; it += nb) {
        OPQ;
            if (it < n1) hgrn_pass1_item(p, l, it, smem, tid);
            else if (it < n1 + 512) conv_item(p, s, l, it - n1, smem, tid);
            else if (it < n1 + 512 + nq) qkprep_item(p, s, l, it - n1 - 512, smem, tid);
            else convert_tile(p, 0, 1024 + it - (n1 + 512 + nq), smem, tid);
          }
        } break;
        case 3:
        {
          const int ncv = (l == 0 && s == 0) ? 2400 : 0;
#if REP
          unsigned* ctr = (unsigned*)(p.ws + OFF_BAR) + 3600 + 4 * q + (pp & 1);
#else
          unsigned* ctr = (unsigned*)(p.ws + OFF_BAR) + 3600 + 4 * q;
#endif
          for (;;) {
            __syncthreads();
            if (threadIdx.x == 0) xb_words.z = atomicAdd(ctr, 1u);
            __syncthreads();
            const int it = (int)xb_words.z;
            if (it >= 256 + 512 + ncv) break;
            if (s == 0 && it < 256) continue;
#if REP
            if ((pp & 1) && (REP & 0x10000) && it < 256) continue;
            if ((pp & 1) && (REP & 0x20000) && it >= 256 && it < 768) continue;
#endif
        OPQ;
            if (it < 256) hgrn_pass2_item(p, s, l, it, smem, tid);
            else if (it < 768) attn_item(p, s, l, it - 256, smem, tid);
            else convert_tile(p, 1, it - 768, smem, tid);
          }
        }
          break;
        case 4: for (int it = bid; it < 1024; it += nb) { OPQ; hgrn_fin_item(p, s, l, it, tid); } break;
        case 5: for (int it = bid; it < 512; it += nb) { OPQ; branch_tile(p, l, it, smem, tid); } break;
        case 6: for (int it = bid; it < 512; it += nb) { OPQ; resid_tile(p, s, l, 0, it, smem, tid); } break;
        case 7: for (int it = bid; it < 512; it += nb) { OPQ; norm_item(p, s, l, 1, it, tid); } break;
        case 8: for (int it = bid; it < 64 * 44; it += nb) { OPQ; ffnin_tile(p, l, it, smem, tid); } break;
        case 9: {
          const int nn = (q < 30) ? 512 : 0;
          const int s2 = s ^ 1, l2 = l + s;
          for (int it = bid; it < 512 + nn; it += nb) {
        OPQ;
            if (it < 512) resid_tile(p, s, l, 1, it, smem, tid);
            else norm_item(p, s2, l2, 0, it - 512, tid);
          }
        } break;
      }
    }
#if REP
    if (pp + 1 < 2 * ph_hi) {
#else
    if (ph + 1 < ph_hi) {
#endif
      if (ph_hi > 100000) cg::this_grid().sync();
      xcd_barrier(xb);
    }
  }
}

extern "C" void kernel_launch(void* const* d_in, const int* in_sizes, int n_in, void* d_out, int out_size, void* d_ws, size_t ws_size,
                              hipStream_t stream) {
  static int grid_blocks = 0;
  if (!grid_blocks) {
    int dev = 0, cus = 0, per_cu = 0;
    hipGetDevice(&dev);
    hipDeviceGetAttribute(&cus, hipDeviceAttributeMultiprocessorCount, dev);
    hipOccupancyMaxActiveBlocksPerMultiprocessor(&per_cu, fwd_kernel, 256, 0);
    if (per_cu < 1) per_cu = 1;
    if (per_cu > 2) per_cu = 2;
    grid_blocks = cus * per_cu;
  }
  if (ws_size < WS_END) { fprintf(stderr, "workspace too small: %zu < %zu\n", ws_size, (size_t)WS_END); return; }
  Params p{};
  for (int i = 0; i < 26; ++i) p.in[i] = (const float*)d_in[i];
  p.out = (float*)d_out;
  p.ws = (char*)d_ws;
#if MEGA
  hipMemsetAsync((char*)d_ws + OFF_BAR, 0, 16384, stream);
  int lo = 0, hi = NPH;
  void* args[] = {&p, &lo, &hi};
  hipError_t e = hipLaunchCooperativeKernel((void*)fwd_kernel, dim3(grid_blocks), dim3(256), args, 0, stream);
  if (e != hipSuccess) fprintf(stderr, "cooperative launch failed: %s (grid %d)\n", hipGetErrorString(e), grid_blocks);
#else
  for (int ph = 0; ph < NPH; ++ph) fwd_kernel<<<grid_blocks, 256, 0, stream>>>(p, ph, ph + 1);
#endif
}
```
